# Optimizing an MI355X kernel written in HIP

```python
import jax, jax.numpy as jnp
from jax import lax
import numpy as np


D_MODEL = 1024
BATCH = 4
SEQ = 8192
DEPTH = 1

CHUNK = 64
GM_BLOCK = 128
GM_GROUP_DIM = 128
GM_WIDTH = D_MODEL
GM_GROUPS = GM_WIDTH // GM_GROUP_DIM
HG_DK = 128
HG_DV = 128
HG_HEADS = D_MODEL // 128
HG_KWIDTH = HG_HEADS * HG_DK
HG_WIDTH = HG_HEADS * HG_DV
HG_CHUNK = 16
D_FF = -((-8 * D_MODEL) // (3 * 256)) * 256
PLE_DIM = 256
ALPHA = (2.0 * DEPTH) ** 0.25
BETA = (8.0 * DEPTH) ** -0.25
LN_EPS = 1e-5
RMS_EPS = 1e-6
IN_SPLITS = (GM_WIDTH, GM_WIDTH, HG_KWIDTH, HG_KWIDTH, HG_WIDTH, HG_WIDTH, D_MODEL, D_MODEL)
D_IN = sum(IN_SPLITS)
IN_OFFSETS = tuple(int(o) for o in np.cumsum(IN_SPLITS)[:-1])

kernel_name = "hybrid_gmlp_hgrn2_deepnorm_block"


def _layer_norm(x, g, b):
    xf = x.astype(jnp.float32)
    xc = xf - jnp.mean(xf, -1, keepdims=True)
    var = jnp.mean(xc * xc, -1, keepdims=True)
    y = xc * lax.rsqrt(var + LN_EPS) * g.astype(jnp.float32) + b.astype(jnp.float32)
    return y.astype(x.dtype)


def _rms_norm(x, g):
    return x * lax.rsqrt(jnp.mean(x * x, -1, keepdims=True) + RMS_EPS) * g


def _gmlp_spatial_gate(u, v, v_g, v_b, w_s, b_s):
    bsz, seq, _ = v.shape
    pos = jnp.arange(GM_BLOCK)
    mask = (pos[:, None] // CHUNK) >= (pos[None, :] // CHUNK)
    w = jnp.where(mask[None], w_s, jnp.zeros_like(w_s))
    vn = _layer_norm(v, v_g, v_b).reshape(bsz, seq // GM_BLOCK, GM_BLOCK, GM_GROUPS, GM_GROUP_DIM)
    mixed = jnp.einsum("gts,bnsgc->bntgc", w, vn) + b_s.T[:, :, None]
    return u * mixed.reshape(bsz, seq, GM_WIDTH)


def _hgrn2(q_raw, f_raw, i_raw, g_raw, lb, o_g):
    bsz, seq, _ = q_raw.shape
    nc = seq // HG_CHUNK
    f32 = jnp.float32

    def heads(t, d):
        return t.astype(f32).reshape(bsz, nc, HG_CHUNK, HG_HEADS, d)

    lbf = lb.astype(f32)
    fr = f_raw.astype(f32)
    log_f = heads(jnp.log(lbf + (1.0 - lbf) * jax.nn.sigmoid(fr)), HG_DK)
    k = heads((1.0 - lbf) * jax.nn.sigmoid(-fr), HG_DK)
    q = heads(jax.nn.silu(q_raw.astype(f32)), HG_DK)
    v = heads(i_raw, HG_DV)
    b = jnp.cumsum(log_f, axis=2)
    q_dec = q * jnp.exp(b)
    k_dec = k * jnp.exp(-b)
    causal = jnp.tril(jnp.ones((HG_CHUNK, HG_CHUNK), f32))
    scores = jnp.einsum("bnthd,bnshd->bnhts", q_dec, k_dec) * causal
    o_intra = jnp.einsum("bnhts,bnshe->bnthe", scores, v)
    b_last = b[:, :, -1:]
    k_end = k * jnp.exp(b_last - b)
    decay = jnp.exp(b_last[:, :, 0])

    def step(state, xs):
        qc, kc, vc, dc = xs
        o = jnp.einsum("bthd,bhde->bthe", qc, state)
        state = dc[..., None] * state + jnp.einsum("bthd,bthe->bhde", kc, vc)
        return state, o

    s0 = jnp.zeros((bsz, HG_HEADS, HG_DK, HG_DV), f32)
    _, o_inter = lax.scan(step, s0, (jnp.moveaxis(q_dec, 1, 0), jnp.moveaxis(k_end, 1, 0),
                                     jnp.moveaxis(v, 1, 0), jnp.moveaxis(decay, 1, 0)))
    o = (o_intra + jnp.moveaxis(o_inter, 0, 1)).reshape(bsz, seq, HG_HEADS, HG_DV)
    o = _rms_norm(o, o_g.astype(f32).reshape(HG_HEADS, HG_DV)).reshape(bsz, seq, HG_WIDTH)
    o = o * jax.nn.silu(g_raw.astype(f32))
    return o.astype(q_raw.dtype)


def setup_inputs(seed: int = 0) -> dict:
    key = jax.random.key(seed)
    ks = jax.random.split(key, 26)
    f32 = jnp.float32
    L = DEPTH

    def nrm(k, shape, scale):
        return jax.random.normal(k, shape, f32) * scale

    def gain(k, shape):
        return 1.0 + nrm(k, shape, 0.02)

    return {
        "x": nrm(ks[0], (BATCH, SEQ, D_MODEL), 1.0),
        "p": nrm(ks[1], (DEPTH, BATCH, SEQ, PLE_DIM), 1.0),
        "ln0_g": gain(ks[2], (D_MODEL,)),
        "ln0_b": nrm(ks[3], (D_MODEL,), 0.02),
        "w_in": nrm(ks[4], (L, D_MODEL, D_IN), D_MODEL ** -0.5),
        "b_in": nrm(ks[5], (L, D_IN), 0.02),
        "gm_norm_g": gain(ks[6], (L, GM_WIDTH)),
        "gm_norm_b": nrm(ks[7], (L, GM_WIDTH), 0.02),
        "gm_w_s": nrm(ks[8], (L, GM_GROUPS, GM_BLOCK, GM_BLOCK), 0.5 * GM_BLOCK ** -0.5),
        "gm_b_s": gain(ks[9], (L, GM_GROUPS, GM_BLOCK)),
        "hg_lb_logits": nrm(ks[10], (L + 1, HG_KWIDTH), 0.5),
        "hg_norm_g": gain(ks[11], (L, HG_WIDTH)),
        "w_a": nrm(ks[12], (L, GM_WIDTH, D_MODEL), BETA * GM_WIDTH ** -0.5),
        "w_b": nrm(ks[13], (L, HG_WIDTH, D_MODEL), BETA * HG_WIDTH ** -0.5),
        "w_o": nrm(ks[14], (L, D_MODEL, D_MODEL), BETA * D_MODEL ** -0.5),
        "ln1_g": gain(ks[15], (L, D_MODEL)),
        "ln1_b": nrm(ks[16], (L, D_MODEL), 0.02),
        "w_ffn_gate": nrm(ks[17], (L, D_MODEL, D_FF), D_MODEL ** -0.5),
        "w_ffn_up": nrm(ks[18], (L, D_MODEL, D_FF), BETA * D_MODEL ** -0.5),
        "w_ffn_down": nrm(ks[19], (L, D_FF, D_MODEL), BETA * D_FF ** -0.5),
        "w_ple": nrm(ks[20], (L, PLE_DIM, D_MODEL), PLE_DIM ** -0.5),
        "w_ple_gate": nrm(ks[21], (L, D_MODEL, D_MODEL), D_MODEL ** -0.5),
        "b_ple_gate": nrm(ks[22], (L, D_MODEL), 0.02),
        "ln2_g": gain(ks[23], (L, D_MODEL)),
        "ln2_b": nrm(ks[24], (L, D_MODEL), 0.02),
    }


def reference(x, p, ln0_g, ln0_b, w_in, b_in, gm_norm_g, gm_norm_b, gm_w_s, gm_b_s,
              hg_lb_logits, hg_norm_g, w_a, w_b, w_o, ln1_g, ln1_b,
              w_ffn_gate, w_ffn_up, w_ffn_down, w_ple, w_ple_gate, b_ple_gate, ln2_g, ln2_b):
    lb_all = jnp.cumsum(jax.nn.softmax(hg_lb_logits.astype(jnp.float32), axis=0), axis=0)
    h = _layer_norm(x, ln0_g, ln0_b)
    for i in range(DEPTH):
        proj = jnp.einsum("bsd,de->bse", h, w_in[i]) + b_in[i]
        u_r, v_r, q_r, f_r, i_r, g_r, ga_r, gb_r = jnp.split(proj, IN_OFFSETS, axis=-1)
        y_a = _gmlp_spatial_gate(jax.nn.gelu(u_r), jax.nn.gelu(v_r), gm_norm_g[i], gm_norm_b[i],
                                 gm_w_s[i], gm_b_s[i])
        y_b = _hgrn2(q_r, f_r, i_r, g_r, lb_all[i], hg_norm_g[i])
        merged = (jax.nn.sigmoid(ga_r) * jnp.einsum("bsc,cd->bsd", y_a, w_a[i])
                  + jax.nn.sigmoid(gb_r) * jnp.einsum("bsc,cd->bsd", y_b, w_b[i]))
        mix = jnp.einsum("bsd,de->bse", merged, w_o[i])
        h1 = _layer_norm(ALPHA * h + mix, ln1_g[i], ln1_b[i])
        hid = jax.nn.silu(jnp.einsum("bsd,df->bsf", h1, w_ffn_gate[i])) * jnp.einsum("bsd,df->bsf", h1, w_ffn_up[i])
        ffn = jnp.einsum("bsf,fd->bsd", hid, w_ffn_down[i])
        ple = (jax.nn.sigmoid(jnp.einsum("bsd,de->bse", h1, w_ple_gate[i]) + b_ple_gate[i])
               * jnp.einsum("bsr,rd->bsd", p[i], w_ple[i]))
        h = _layer_norm(ALPHA * h1 + ffn + ple, ln2_g[i], ln2_b[i])
    return h
```

```cpp
#include <hip/hip_runtime.h>
#include <hip/hip_cooperative_groups.h>
#include <cstdio>
namespace cg = cooperative_groups;

#ifndef BF_P1
#define BF_P1 1
#endif
#ifndef BF_P9
#define BF_P9 1
#endif
#ifndef USE_XCD
#define USE_XCD 1
#endif
#ifndef MK_MULTI
#define MK_MULTI 0
#endif

#define LAS __attribute__((address_space(3)))
typedef _Float16 half_t;
typedef _Float16 h8 __attribute__((ext_vector_type(8)));
typedef _Float16 h4 __attribute__((ext_vector_type(4)));
typedef _Float16 h2 __attribute__((ext_vector_type(2)));
typedef short s8v __attribute__((ext_vector_type(8)));
typedef float f32x4 __attribute__((ext_vector_type(4)));
typedef __bf16 bf8v __attribute__((ext_vector_type(8)));
typedef float f32x2 __attribute__((ext_vector_type(2)));

constexpr int T = 32768, DM = 1024, DIN = 8192, DFF = 2816, PLE = 256, YAB = 2048, HPW = 3072;
constexpr float ALPHA = 1.189207115002721f;
constexpr size_t MiB = (size_t)1 << 20;
constexpr size_t OFF_WIN = 0, OFF_WA = 16 * MiB, OFF_WB = 18 * MiB, OFF_WO = 20 * MiB, OFF_WGU = 22 * MiB, OFF_WD = 35 * MiB, OFF_WPLE = 40 * MiB + 512 * 1024;
constexpr size_t OFF_BINP = 41 * MiB, OFF_LB = 41 * MiB + 32768, OFF_ST0 = 41 * MiB + 65536, OFF_DSEG = 42 * MiB, OFF_DECAY = 43 * MiB;
constexpr size_t OFF_BAR = 52 * MiB;
constexpr size_t OFF_S1 = 64 * MiB, OFF_S2 = 128 * MiB, OFF_S3 = 192 * MiB, OFF_S4 = 256 * MiB, OFF_S5 = 320 * MiB, OFF_S6 = 384 * MiB, OFF_S7 = 448 * MiB, OFF_P16 = 496 * MiB;
constexpr size_t WS_NEED = 512 * MiB;
#ifndef PROG_LIST
#define PROG_LIST 0, 1, 2, 3, 4, 5, 7, 8, 9, 11, 12
#endif
__device__ const int PROG[] = {PROG_LIST};
constexpr int PROG_HOST[] = {PROG_LIST};
constexpr int NPH = sizeof(PROG_HOST) / sizeof(int);

struct Params {
    const float *x, *p, *ln0_g, *ln0_b, *w_in, *b_in, *gm_g, *gm_b, *gm_ws, *gm_bs, *lbl, *hg_g, *w_a, *w_b, *w_o, *ln1_g, *ln1_b, *wg, *wu, *wd, *wple, *wpg, *bpg, *ln2_g, *ln2_b;
    float* out; unsigned char* ws;
    int ph0, ph1;
};

__device__ __forceinline__ int otid() { int t; asm volatile("v_mov_b32 %0, %1" : "=v"(t) : "v"((int)threadIdx.x)); return t; }
__device__ __forceinline__ int vopq(int x) { int t; asm volatile("v_mov_b32 %0, %1" : "=v"(t) : "v"(x)); return t; }
#define GAS __attribute__((address_space(1)))
template <class Tp> __device__ __forceinline__ Tp* GP(Tp* p) { return (Tp*)(Tp GAS*)p; }
typedef const Params __attribute__((address_space(4)))* KP;
__device__ __forceinline__ KP kp_get() { unsigned long long v; asm volatile("s_mov_b64 %0, %1" : "=s"(v) : "s"((unsigned long long)__builtin_amdgcn_kernarg_segment_ptr())); return (KP)v; }
__device__ __forceinline__ unsigned char* sopq(unsigned char* p) { unsigned long long v; asm volatile("s_mov_b64 %0, %1" : "=s"(v) : "s"((unsigned long long)p)); return (unsigned char*)(unsigned char GAS*)v; }
__device__ __forceinline__ float sigm(float x) { return __builtin_amdgcn_rcpf(1.f + __expf(-x)); }
__device__ __forceinline__ float wave_sum(float v) {
#pragma unroll
    for (int o = 1; o < 64; o <<= 1) v += __shfl_xor(v, o);
    return v;
}
__device__ __forceinline__ unsigned short f2bf(float f) { unsigned u = __float_as_uint(f); u += 0x7FFFu + ((u >> 16) & 1u); return (unsigned short)(u >> 16); }
__device__ __forceinline__ h8 pack8(f32x4 a, f32x4 b) { h8 v; v[0] = (half_t)a[0]; v[1] = (half_t)a[1]; v[2] = (half_t)a[2]; v[3] = (half_t)a[3]; v[4] = (half_t)b[0]; v[5] = (half_t)b[1]; v[6] = (half_t)b[2]; v[7] = (half_t)b[3]; return v; }
__device__ __forceinline__ s8v pack8b(f32x4 a, f32x4 b) { s8v v;
#pragma unroll
    for (int i = 0; i < 4; ++i) { v[i] = (short)f2bf(a[i]); v[4 + i] = (short)f2bf(b[i]); }
    return v; }
#define MFMA16_KEEP(a, b) asm volatile("" :: "v"(a), "v"(b))
__device__ __forceinline__ int map_win(int r) {
    if (r < 2048 || (r >= 4096 && r < 6144)) return r;
    const int rho = r & 255;
    if (r >= 6144) { const int j = (r - 6144) >> 8; return rho < 128 ? 6144 + 128 * j + rho : 7168 + 128 * j + rho - 128; }
    const int h = (r - 2048) >> 8;
    return rho < 128 ? 2048 + 128 * h + rho : 3072 + 128 * h + rho - 128;
}

namespace pg8 {
constexpr int BM = 256, BK = 64, HALF = 128, HTB = HALF * BK * 2, STAGE_BYTES = 8 * HTB, NXCD = 8, WGM = 8;
__host__ __device__ __forceinline__ int lds_byte(int r, int c) { const int st = (r >> 4) * 2 + (c >> 5), rr = r & 15, cc = c & 31, ob = rr * 64 + cc * 2; return st * 1024 + (ob ^ (((ob >> 9) & 1) << 5)); }
__host__ __device__ __forceinline__ void stage_rc(int b, int& R, int& C) { const int st = b / 1024, sb = b % 1024, swz = sb ^ (((sb >> 9) & 1) << 5); R = (st >> 1) * 16 + swz / 64; C = (st & 1) * 32 + (swz % 64) / 2; }
__host__ __device__ __forceinline__ int perm32(int rho) { const int n = rho >> 4, i = rho & 15; return 8 * (i >> 2) + 4 * n + (i & 3); }
struct Unit { int pm, pn; };
struct Gemm { const half_t* A; const half_t* Bt; int M, N, K; };
struct StaticOrder {
    int nM, nN, nwg, G, c;
    __host__ __device__ void init(int M, int N, int G_, int c_) { nM = M / BM; nN = N / BM; nwg = nM * nN; G = G_; c = c_; }
    __host__ __device__ bool next(int i, Unit& u) const {
        const long L = (long)i * G + c; if (L >= nwg) return false;
        int wgid = (int)L; { const int q = nwg / NXCD, r = nwg % NXCD, xcd = wgid % NXCD, off = wgid / NXCD; wgid = (xcd < r ? xcd * (q + 1) : r * (q + 1) + (xcd - r) * q) + off; }
        const int nig = WGM * nN, gid = wgid / nig, fm = gid * WGM, gsz = (nM - fm) < WGM ? (nM - fm) : WGM;
        u.pm = fm + ((wgid % nig) % gsz); u.pn = (wgid % nig) / gsz; return true;
    }
};

template <class Epi, bool BF = false>
__device__ __forceinline__ void gemm_phase(LAS unsigned char* lds, const Gemm g, const StaticOrder& S, const Epi& E) {
    const int tid = otid(), wid = __builtin_amdgcn_readfirstlane(tid >> 6), lane = tid & 63, wr = wid >> 2, wc = wid & 3, fr = lane & 15, fq = lane >> 4;
    const int K = g.K, nt = K / BK;
    unsigned voffA[2], voffB[2];
#pragma unroll
    for (int i = 0; i < 2; ++i) { int R, C; stage_rc(tid * 16 + i * 8192, R, C); const int Rb = (R & ~31) + perm32(R & 31);
        voffA[i] = (unsigned)(R * K + C) * 2u; voffB[i] = (unsigned)(Rb * K + C) * 2u; }
    const size_t kstep = (size_t)(BK * 2);
    const size_t hstep = (size_t)HALF * K * 2;
    const size_t tstep = 2 * hstep;
    const unsigned ldsw = (unsigned)wid * 1024u;
    const int aoff = lds_byte(wr * 64 + fr, fq * 8), boff = lds_byte(wc * 32 + fr, fq * 8);
#define PG8_SA(b, h) (((b) * 2 + (h)) * HTB)
#define PG8_SB(b, h) ((4 + (b) * 2 + (h)) * HTB)
#define PG8_STAGE(bufoff, gbase, voff) do { _Pragma("unroll") for (int _i = 0; _i < 2; ++_i) \
        __builtin_amdgcn_global_load_lds((const unsigned*)((const char*)(gbase) + (voff)[_i]), (LAS unsigned*)(lds + (bufoff) + ldsw + _i * 8192), 16, 0, 0); } while (0)
#define PG8_LDA(dst, b, h) do { _Pragma("unroll") for (int m = 0; m < 4; ++m) _Pragma("unroll") for (int k = 0; k < 2; ++k) dst[m][k] = *(const LAS h8*)(lds + PG8_SA(b, h) + aoff + m * 2048 + k * 1024); } while (0)
#define PG8_LDB(dst, b, h) do { _Pragma("unroll") for (int n = 0; n < 2; ++n) _Pragma("unroll") for (int k = 0; k < 2; ++k) dst[n][k] = *(const LAS h8*)(lds + PG8_SB(b, h) + boff + n * 2048 + k * 1024); } while (0)
#define PG8_MMA(ai, bj, At, Bt) do { __builtin_amdgcn_s_setprio(1); _Pragma("unroll") for (int m = 0; m < 4; ++m) _Pragma("unroll") for (int n = 0; n < 2; ++n) _Pragma("unroll") for (int k = 0; k < 2; ++k) \
        acc[ai][bj][m][n] = BF ? __builtin_amdgcn_mfma_f32_16x16x32_bf16(__builtin_bit_cast(bf8v, Bt[n][k]), __builtin_bit_cast(bf8v, At[m][k]), acc[ai][bj][m][n], 0, 0, 0) \
                               : __builtin_amdgcn_mfma_f32_16x16x32_f16(Bt[n][k], At[m][k], acc[ai][bj][m][n], 0, 0, 0); __builtin_amdgcn_s_setprio(0); } while (0)
#define PG8_WAIT_V(n) asm volatile("s_waitcnt vmcnt(" #n ")" ::: "memory")
#define PG8_WAIT_L(n) asm volatile("s_waitcnt lgkmcnt(" #n ")" ::: "memory")
#define PG8_BAR __builtin_amdgcn_s_barrier()
#define PG8_SCHED __builtin_amdgcn_sched_barrier(0)
    Unit cur, nxt; int ui = 0;
    if (!S.next(0, cur)) return;
    f32x4 acc[2][2][4][2];
#pragma unroll
    for (int a = 0; a < 2; ++a)
#pragma unroll
        for (int b = 0; b < 2; ++b)
#pragma unroll
            for (int m = 0; m < 4; ++m)
#pragma unroll
                for (int n = 0; n < 2; ++n) acc[a][b][m][n] = (f32x4){0.f, 0.f, 0.f, 0.f};
    h8 At[4][2], B0[2][2], B1[2][2];
    const char* cA = (const char*)sopq((unsigned char*)g.A) + (size_t)cur.pm * tstep; const char* cB = (const char*)sopq((unsigned char*)g.Bt) + (size_t)cur.pn * tstep;
    PG8_STAGE(PG8_SB(0, 0), cB, voffB); PG8_STAGE(PG8_SA(0, 0), cA, voffA); PG8_STAGE(PG8_SB(0, 1), cB + hstep, voffB); PG8_STAGE(PG8_SA(0, 1), cA + hstep, voffA);
    if (wr == 1) PG8_BAR;
    PG8_WAIT_V(4); PG8_BAR;
    PG8_STAGE(PG8_SB(1, 0), cB + kstep, voffB); PG8_STAGE(PG8_SA(1, 0), cA + kstep, voffA); PG8_STAGE(PG8_SB(1, 1), cB + hstep + kstep, voffB);
    PG8_WAIT_V(6); PG8_BAR;
    for (;;) {
        const bool has_next = S.next(ui + 1, nxt);
        const char* nA = has_next ? (const char*)sopq((unsigned char*)g.A) + (size_t)nxt.pm * tstep : cA; const char* nB = has_next ? (const char*)sopq((unsigned char*)g.Bt) + (size_t)nxt.pn * tstep : cB;
        for (int t = 0; t < nt; t += 2) {
            if (t == E.hook_t) E.mid(acc, cur, wr, wc, fr, fq);
            const bool last = (t == nt - 2);
            const char* a1 = cA + (size_t)(t + 1) * kstep;
            const char* a2 = last ? nA : cA + (size_t)(t + 2) * kstep; const char* b2 = last ? nB : cB + (size_t)(t + 2) * kstep;
            const char* a3 = a2 + kstep; const char* b3 = b2 + kstep;
            PG8_LDB(B0, 0, 0); PG8_SCHED; PG8_LDA(At, 0, 0); PG8_STAGE(PG8_SA(1, 1), a1 + hstep, voffA);
            PG8_WAIT_L(8); PG8_BAR; PG8_WAIT_L(0); PG8_MMA(0, 0, At, B0); PG8_BAR; PG8_SCHED;
            PG8_LDB(B1, 0, 1); PG8_STAGE(PG8_SB(0, 0), b2, voffB);
            PG8_BAR; PG8_WAIT_L(0); PG8_MMA(0, 1, At, B1); PG8_BAR;
            PG8_LDA(At, 0, 1); PG8_STAGE(PG8_SA(0, 0), a2, voffA);
            PG8_BAR; PG8_WAIT_L(0); PG8_MMA(1, 0, At, B0); PG8_BAR; PG8_SCHED;
            PG8_STAGE(PG8_SB(0, 1), b2 + hstep, voffB);
            PG8_WAIT_V(6); PG8_BAR; PG8_MMA(1, 1, At, B1); PG8_BAR;
            PG8_LDB(B0, 1, 0); PG8_SCHED; PG8_LDA(At, 1, 0); PG8_STAGE(PG8_SA(0, 1), a2 + hstep, voffA);
            PG8_WAIT_L(8); PG8_BAR; PG8_WAIT_L(0); PG8_MMA(0, 0, At, B0); PG8_BAR; PG8_SCHED;
            PG8_LDB(B1, 1, 1); PG8_STAGE(PG8_SB(1, 0), b3, voffB);
            PG8_BAR; PG8_WAIT_L(0); PG8_MMA(0, 1, At, B1); PG8_BAR;
            PG8_LDA(At, 1, 1); PG8_STAGE(PG8_SA(1, 0), a3, voffA);
            PG8_BAR; PG8_WAIT_L(0); PG8_MMA(1, 0, At, B0); PG8_BAR; PG8_SCHED;
            PG8_STAGE(PG8_SB(1, 1), b3 + hstep, voffB);
            PG8_WAIT_V(6); PG8_BAR; PG8_MMA(1, 1, At, B1); PG8_BAR;
        }
        E(acc, cur, wr, wc, fr, fq);
        if (!has_next) break;
#pragma unroll
        for (int a = 0; a < 2; ++a)
#pragma unroll
            for (int b = 0; b < 2; ++b)
#pragma unroll
                for (int m = 0; m < 4; ++m)
#pragma unroll
                    for (int n = 0; n < 2; ++n) acc[a][b][m][n] = (f32x4){0.f, 0.f, 0.f, 0.f};
        cur = nxt; cA = nA; cB = nB; ++ui;
    }
    PG8_WAIT_V(0);
    if (wr == 0) PG8_BAR;
    PG8_BAR;
#undef PG8_SA
#undef PG8_SB
#undef PG8_STAGE
#undef PG8_LDA
#undef PG8_LDB
#undef PG8_MMA
#undef PG8_WAIT_V
#undef PG8_WAIT_L
#undef PG8_BAR
#undef PG8_SCHED
}
}

enum { EK_PROJ = 0, EK_MRG, EK_WO, EK_FFN, EK_DOWN, EK_NONE };

__device__ __forceinline__ float dpp_shr_add(float v, int) { return v; }
template <int CTRL> __device__ __forceinline__ float dpp_shr(float v) {
    return __builtin_bit_cast(float, __builtin_amdgcn_update_dpp(0, __builtin_bit_cast(int, v), CTRL, 0xf, 0xf, true));
}
__device__ __forceinline__ float row_scan16(float v) {
    v += dpp_shr<0x111>(v); v += dpp_shr<0x112>(v); v += dpp_shr<0x114>(v); v += dpp_shr<0x118>(v); return v;
}

template <int CTRL> __device__ __forceinline__ float dpp_shr1(float v) {
    return __builtin_bit_cast(float, __builtin_amdgcn_update_dpp(0x3f800000, __builtin_bit_cast(int, v), CTRL, 0xf, 0xf, false));
}
__device__ __forceinline__ float row_scanmul16(float v) {
    v *= dpp_shr1<0x111>(v); v *= dpp_shr1<0x112>(v); v *= dpp_shr1<0x114>(v); v *= dpp_shr1<0x118>(v); return v;
}
constexpr int LDS_BIAS = pg8::STAGE_BYTES + 16, LDS_LB = LDS_BIAS + DIN * 2, LDS_TOTAL = LDS_LB + DM * 4;
__device__ __forceinline__ f32x4 ldb4(const LAS half_t* p, int i) { const h4 v = *(const LAS h4*)(p + i); return (f32x4){(float)v[0], (float)v[1], (float)v[2], (float)v[3]}; }
struct Epi {
    int kind, hook_t;
    KP P;
    LAS unsigned char* lds;
    __device__ __forceinline__ void mid(f32x4 (&acc)[2][2][4][2], const pg8::Unit& u, int wr, int wc, int fr, int fq) const {
        unsigned char* ws = sopq(GP(P->ws));
        const int tid_ = otid(), lane_ = tid_ & 63, wid_ = tid_ >> 6;
        const int rowb = u.pm * 256 + (wid_ >> 2) * 64 + (lane_ & 15);
        const int c8 = (wid_ & 3) * 32 + (lane_ >> 4) * 8;
        const half_t* gsrc = kind == EK_MRG ? (const half_t*)GP(P->out) : (const half_t*)(ws + OFF_S2);
#pragma unroll
        for (int ai = 0; ai < 2; ++ai) {
            h8 gv[4][2];
#pragma unroll
            for (int m = 0; m < 4; ++m)
#pragma unroll
                for (int bj = 0; bj < 2; ++bj) gv[m][bj] = *(const h8*)(gsrc + (size_t)(rowb + ai * 128 + m * 16) * DM + u.pn * 256 + 128 * bj + c8);
            asm volatile("" ::: "memory");
#pragma unroll
            for (int m = 0; m < 4; ++m)
#pragma unroll
                for (int bj = 0; bj < 2; ++bj)
#pragma unroll
                    for (int j = 0; j < 4; ++j) { acc[ai][bj][m][0][j] *= (float)gv[m][bj][j]; acc[ai][bj][m][1][j] *= (float)gv[m][bj][4 + j]; }
            asm volatile("" ::: "memory");
        }
    }
    __device__ __forceinline__ void operator()(const f32x4 (&acc)[2][2][4][2], const pg8::Unit& u, int, int, int fr, int) const {
        unsigned char* ws = sopq(GP(P->ws));
        const int tid_ = otid(), lane = tid_ & 63, wid_ = tid_ >> 6;
        const int rowb = u.pm * 256 + (wid_ >> 2) * 64 + (lane & 15);
        const int c8 = (wid_ & 3) * 32 + (lane >> 4) * 8;
        fr = lane & 15;
        if (kind == EK_PROJ) {
            const LAS half_t* binp = (const LAS half_t*)(lds + LDS_BIAS);
            const int pn = u.pn;
            if (pn >= 8 && pn < 16) {
                const int h = pn - 8;
                half_t* Q = (half_t*)(ws + OFF_S4); half_t* F = (half_t*)(ws + OFF_S5); float* decay = (float*)(ws + OFF_DECAY);
                const LAS float* lbp = (const LAS float*)(lds + LDS_LB) + 128 * h + c8;
                const f32x4 lb0 = *(const LAS f32x4*)lbp, lb1 = *(const LAS f32x4*)(lbp + 4);
                const f32x4 bq0 = ldb4(binp, 256 * pn + c8), bq1 = ldb4(binp, 256 * pn + c8 + 4);
                const f32x4 bf0 = ldb4(binp, 256 * pn + 128 + c8), bf1 = ldb4(binp, 256 * pn + 128 + c8 + 4);
                const int src_last = ((lane | 15) << 2);
#pragma unroll
                for (int ai = 0; ai < 2; ++ai)
#pragma unroll
                    for (int m = 0; m < 4; ++m) {
                        const int row = rowb + ai * 128 + m * 16;
                        f32x4 qd[2], ke[2], dc[2];
#pragma unroll
                        for (int n = 0; n < 2; ++n)
#pragma unroll
                            for (int j = 0; j < 4; ++j) {
                                const float lb = n ? lb1[j] : lb0[j];
                                const float qv = acc[ai][0][m][n][j] + (n ? bq1[j] : bq0[j]);
                                const float fv = acc[ai][1][m][n][j] + (n ? bf1[j] : bf0[j]);
                                const float ef = __expf(-fv), sg = __builtin_amdgcn_rcpf(1.f + ef);
                                const float oml = 1.f - lb;
                                const float kk = oml * ef * sg;
                                const float pr = row_scanmul16(lb + oml * sg);
                                const float pl = __builtin_bit_cast(float, __builtin_amdgcn_ds_bpermute(src_last, __builtin_bit_cast(int, pr)));
                                qd[n][j] = qv * sigm(qv) * pr;
                                ke[n][j] = kk * pl * __builtin_amdgcn_rcpf(pr);
                                dc[n][j] = pl;
                            }
                        const size_t o = (size_t)row * DM + 128 * h + c8;
                        *(h8*)(Q + o) = pack8(qd[0], qd[1]);
                        *(h8*)(F + o) = pack8(ke[0], ke[1]);
                        if (fr == 15) { float* dp = decay + (size_t)(row >> 4) * DM + 128 * h + c8; *(f32x4*)dp = dc[0]; *(f32x4*)(dp + 4) = dc[1]; }
                    }
            } else if (pn >= 24) {
                const int j = pn - 24;
                half_t* R = (half_t*)GP(P->out); half_t* SB = (half_t*)GP(P->out) + (size_t)T * DM;
                const f32x4 ba0 = ldb4(binp, 256 * pn + c8), ba1 = ldb4(binp, 256 * pn + c8 + 4);
                const f32x4 bb0 = ldb4(binp, 256 * pn + 128 + c8), bb1 = ldb4(binp, 256 * pn + 128 + c8 + 4);
#pragma unroll
                for (int ai = 0; ai < 2; ++ai)
#pragma unroll
                    for (int m = 0; m < 4; ++m) {
                        const int row = rowb + ai * 128 + m * 16;
                        f32x4 rr[2], sb[2];
#pragma unroll
                        for (int n = 0; n < 2; ++n)
#pragma unroll
                            for (int jj = 0; jj < 4; ++jj) {
                                const float ea = __expf(-(acc[ai][0][m][n][jj] + (n ? ba1[jj] : ba0[jj]))), eb = __expf(-(acc[ai][1][m][n][jj] + (n ? bb1[jj] : bb0[jj])));
                                sb[n][jj] = __builtin_amdgcn_rcpf(1.f + eb);
                                rr[n][jj] = fminf((1.f + eb) * __builtin_amdgcn_rcpf(1.f + ea), 60000.f);
                            }
                        const size_t o = (size_t)row * DM + 128 * j + c8;
                        *(h8*)(R + o) = pack8(rr[0], rr[1]);
                        *(h8*)(SB + o) = pack8(sb[0], sb[1]);
                    }
            } else {
                half_t* dst; int act, colt;
                int ldd = DM;
                if (pn < 4) { dst = (half_t*)(ws + OFF_S2); act = 0; colt = pn * 256; ldd = YAB; }
                else if (pn < 8) { dst = (half_t*)(ws + OFF_S7); act = 0; colt = (pn - 4) * 256; }
                else if (pn < 20) { dst = (half_t*)(ws + OFF_S6); act = 1; colt = (pn - 16) * 256; }

                else { dst = (half_t*)(ws + OFF_S2) + DM; act = 2; colt = (pn - 20) * 256; ldd = YAB; }
#pragma unroll
                for (int bj = 0; bj < 2; ++bj) {
                    const f32x4 b0 = ldb4(binp, 256 * pn + 128 * bj + c8), b1 = ldb4(binp, 256 * pn + 128 * bj + c8 + 4);
#pragma unroll
                    for (int ai = 0; ai < 2; ++ai)
#pragma unroll
                        for (int m = 0; m < 4; ++m) {
                            const int row = rowb + ai * 128 + m * 16;
                            f32x4 r[2];
#pragma unroll
                            for (int n = 0; n < 2; ++n)
#pragma unroll
                                for (int j = 0; j < 4; ++j) {
                                    const float v = acc[ai][bj][m][n][j] + (n ? b1[j] : b0[j]);
                                    const float arg = act == 0 ? 1.5957691216057308f * (v + 0.044715f * v * v * v) : v;
                                    const float s = sigm(arg);
                                    r[n][j] = act == 1 ? v : (act == 3 ? s : v * s);
                                }
                            *(h8*)(dst + (size_t)row * ldd + colt + 128 * bj + c8) = pack8(r[0], r[1]);
                        }
                }
            }
        } else if (kind == EK_MRG) {
            const half_t* gate = (const half_t*)GP(P->out) + (size_t)T * DM;
            half_t* merged = (half_t*)(ws + OFF_S5);
#pragma unroll
            for (int ai = 0; ai < 2; ++ai) {
                h8 gv[4][2];
#pragma unroll
                for (int m = 0; m < 4; ++m)
#pragma unroll
                    for (int bj = 0; bj < 2; ++bj) gv[m][bj] = *(const h8*)(gate + (size_t)(rowb + ai * 128 + m * 16) * DM + u.pn * 256 + 128 * bj + c8);
                asm volatile("" ::: "memory");
#pragma unroll
                for (int m = 0; m < 4; ++m)
#pragma unroll
                    for (int bj = 0; bj < 2; ++bj) {
                        const size_t o = (size_t)(rowb + ai * 128 + m * 16) * DM + u.pn * 256 + 128 * bj + c8;
                        f32x4 r0, r1;
#pragma unroll
                        for (int j = 0; j < 4; ++j) { r0[j] = (float)gv[m][bj][j] * acc[ai][bj][m][0][j]; r1[j] = (float)gv[m][bj][4 + j] * acc[ai][bj][m][1][j]; }
                        *(h8*)(merged + o) = pack8(r0, r1);
                    }
                asm volatile("" ::: "memory");
            }
        } else if (kind == EK_WO) {
            half_t* z1 = (half_t*)(ws + OFF_S3);
            const float* st0 = (const float*)(ws + OFF_ST0);
            f32x4 g0[2], g1[2], b0[2], b1[2];
#pragma unroll
            for (int bj = 0; bj < 2; ++bj) { const int col = u.pn * 256 + 128 * bj + c8;
                g0[bj] = *(const f32x4*)(GP(P->ln0_g) + col); g1[bj] = *(const f32x4*)(GP(P->ln0_g) + col + 4); b0[bj] = *(const f32x4*)(GP(P->ln0_b) + col); b1[bj] = *(const f32x4*)(GP(P->ln0_b) + col + 4); }
#pragma unroll
            for (int ai = 0; ai < 2; ++ai)
#pragma unroll
                for (int mh = 0; mh < 2; ++mh) {
                    f32x2 ms[2]; f32x4 x0[2][2], x1[2][2];
#pragma unroll
                    for (int mm = 0; mm < 2; ++mm) { const int row = rowb + ai * 128 + (2 * mh + mm) * 16;
                        ms[mm] = *(const f32x2*)(st0 + 2 * row);
#pragma unroll
                        for (int bj = 0; bj < 2; ++bj) { const size_t o = (size_t)row * DM + u.pn * 256 + 128 * bj + c8; x0[mm][bj] = *(const f32x4*)(GP(P->x) + o); x1[mm][bj] = *(const f32x4*)(GP(P->x) + o + 4); } }
                    asm volatile("" ::: "memory");
#pragma unroll
                    for (int mm = 0; mm < 2; ++mm)
#pragma unroll
                        for (int bj = 0; bj < 2; ++bj) { const int m = 2 * mh + mm; const size_t o = (size_t)(rowb + ai * 128 + m * 16) * DM + u.pn * 256 + 128 * bj + c8;
                            f32x4 r0, r1;
#pragma unroll
                            for (int j = 0; j < 4; ++j) {
                                r0[j] = ALPHA * ((x0[mm][bj][j] - ms[mm][0]) * ms[mm][1] * g0[bj][j] + b0[bj][j]) + acc[ai][bj][m][0][j];
                                r1[j] = ALPHA * ((x1[mm][bj][j] - ms[mm][0]) * ms[mm][1] * g1[bj][j] + b1[bj][j]) + acc[ai][bj][m][1][j];
                            }
                            *(h8*)(z1 + o) = pack8(r0, r1); }
                    asm volatile("" ::: "memory");
                }
        } else if (kind == EK_FFN) {
            if (u.pn < 22) {
                half_t* hid = (half_t*)(ws + OFF_S5);
#pragma unroll
                for (int ai = 0; ai < 2; ++ai)
#pragma unroll
                    for (int m = 0; m < 4; ++m) {
                        const int row = rowb + ai * 128 + m * 16;
                        f32x4 r[2];
#pragma unroll
                        for (int n = 0; n < 2; ++n)
#pragma unroll
                            for (int j = 0; j < 4; ++j) { const float gt = acc[ai][0][m][n][j]; r[n][j] = gt * sigm(gt) * acc[ai][1][m][n][j]; }
                        *(h8*)(hid + (size_t)row * HPW + PLE + 128 * u.pn + c8) = pack8(r[0], r[1]);
                    }
            } else {
                half_t* pg = (half_t*)(ws + OFF_S2);
#pragma unroll
                for (int bj = 0; bj < 2; ++bj) {
                    const int col = (u.pn - 22) * 256 + 128 * bj + c8;
                    const f32x4 b0 = *(const f32x4*)(GP(P->bpg) + col), b1 = *(const f32x4*)(GP(P->bpg) + col + 4);
#pragma unroll
                    for (int ai = 0; ai < 2; ++ai)
#pragma unroll
                        for (int m = 0; m < 4; ++m) {
                            const int row = rowb + ai * 128 + m * 16;
                            f32x4 r[2];
#pragma unroll
                            for (int n = 0; n < 2; ++n)
#pragma unroll
                                for (int j = 0; j < 4; ++j) r[n][j] = sigm(acc[ai][bj][m][n][j] + (n ? b1[j] : b0[j]));
                            *(h8*)(pg + (size_t)row * DM + col) = pack8(r[0], r[1]);
                        }
                }
            }
        } else if (kind == EK_DOWN) {
            const half_t* h1 = (const half_t*)(ws + OFF_S1);
            half_t* z2 = (half_t*)(ws + OFF_S3);
#pragma unroll
            for (int ai = 0; ai < 2; ++ai) {
                h8 hv[4][2];
#pragma unroll
                for (int m = 0; m < 4; ++m)
#pragma unroll
                    for (int bj = 0; bj < 2; ++bj) hv[m][bj] = *(const h8*)(h1 + (size_t)(rowb + ai * 128 + m * 16) * DM + u.pn * 256 + 128 * bj + c8);
                asm volatile("" ::: "memory");
#pragma unroll
                for (int m = 0; m < 4; ++m)
#pragma unroll
                    for (int bj = 0; bj < 2; ++bj) {
                        const size_t o = (size_t)(rowb + ai * 128 + m * 16) * DM + u.pn * 256 + 128 * bj + c8;
                        f32x4 r0, r1;
#pragma unroll
                        for (int j = 0; j < 4; ++j) { r0[j] = acc[ai][bj][m][0][j] + ALPHA * (float)hv[m][bj][j]; r1[j] = acc[ai][bj][m][1][j] + ALPHA * (float)hv[m][bj][4 + j]; }
                        *(h8*)(z2 + o) = pack8(r0, r1);
                    }
                asm volatile("" ::: "memory");
            }
        }
    }
};

__device__ __forceinline__ void transpose_job(const float* src, int ld, int col0, half_t* dst, int dld, int dk0, int r0, int k0, float* tile, bool bf = false) {
    const int tid = otid();
    f32x4 tv[4];
#pragma unroll
    for (int i = 0; i < 4; ++i) { const int idx = tid + 512 * i, k = idx >> 4, n4 = idx & 15; tv[i] = *(const f32x4*)(src + (size_t)(k0 + k) * ld + col0 + 4 * n4); }
    asm volatile("" ::: "memory");
#pragma unroll
    for (int i = 0; i < 4; ++i) { const int idx = tid + 512 * i, k = idx >> 4, n4 = idx & 15; *(f32x4*)(tile + k * 68 + 4 * n4) = tv[i]; }
    __syncthreads();
#pragma unroll
    for (int i = 0; i < 2; ++i) { const int idx = tid + 512 * i, n = idx & 63, k8 = idx >> 6; h8 v; s8v vb;
#pragma unroll
        for (int j = 0; j < 8; ++j) { const float t = tile[(8 * k8 + j) * 68 + n]; v[j] = (half_t)t; vb[j] = (short)f2bf(t); }
        if (bf) *(s8v*)(dst + (size_t)(r0 + n) * dld + dk0 + k0 + 8 * k8) = vb; else *(h8*)(dst + (size_t)(r0 + n) * dld + dk0 + k0 + 8 * k8) = v; }
    __syncthreads();
}
__device__ __forceinline__ void ln_row(const float* xr, const float* g, const float* b, half_t* o16, float* o32, float* stat, int lane) {
    f32x4 v[4]; float s = 0.f;
#pragma unroll
    for (int j = 0; j < 4; ++j) { v[j] = *(const f32x4*)(xr + 4 * lane + 256 * j); s += (v[j][0] + v[j][1]) + (v[j][2] + v[j][3]); }
    const float mean = wave_sum(s) * (1.f / DM); float s2 = 0.f;
#pragma unroll
    for (int j = 0; j < 4; ++j) { v[j] = v[j] - mean; s2 += (v[j][0] * v[j][0] + v[j][1] * v[j][1]) + (v[j][2] * v[j][2] + v[j][3] * v[j][3]); }
    const float rstd = 1.f / sqrtf(wave_sum(s2) * (1.f / DM) + 1e-5f);
    if (stat && lane == 0) { stat[0] = mean; stat[1] = rstd; }
#pragma unroll
    for (int j = 0; j < 4; ++j) {
        const f32x4 gg = *(const f32x4*)(g + 4 * lane + 256 * j), bb = *(const f32x4*)(b + 4 * lane + 256 * j);
        const f32x4 y = v[j] * rstd * gg + bb;
        if (o16) { h4 hv; hv[0] = (half_t)y[0]; hv[1] = (half_t)y[1]; hv[2] = (half_t)y[2]; hv[3] = (half_t)y[3]; *(h4*)(o16 + 4 * lane + 256 * j) = hv; }
        if (o32) *(f32x4*)(o32 + 4 * lane + 256 * j) = y;
    }
}
__device__ __forceinline__ void ln_row16(const half_t* xr, const float* g, const float* b, half_t* o16, float* o32, int lane, unsigned short* ob16 = nullptr) {
    const h8 a = *(const h8*)(xr + 8 * lane), c = *(const h8*)(xr + 512 + 8 * lane);
    float v[16]; float s = 0.f;
#pragma unroll
    for (int i = 0; i < 8; ++i) { v[i] = (float)a[i]; v[8 + i] = (float)c[i]; s += v[i] + v[8 + i]; }
    const float mean = wave_sum(s) * (1.f / DM); float s2 = 0.f;
#pragma unroll
    for (int i = 0; i < 16; ++i) { v[i] -= mean; s2 += v[i] * v[i]; }
    const float rstd = 1.f / sqrtf(wave_sum(s2) * (1.f / DM) + 1e-5f);
#pragma unroll
    for (int hf = 0; hf < 2; ++hf) {
        const int col = 512 * hf + 8 * lane;
        const f32x4 g0 = *(const f32x4*)(g + col), g1 = *(const f32x4*)(g + col + 4), b0 = *(const f32x4*)(b + col), b1 = *(const f32x4*)(b + col + 4);
        f32x4 y0, y1;
#pragma unroll
        for (int j = 0; j < 4; ++j) { y0[j] = v[8 * hf + j] * rstd * g0[j] + b0[j]; y1[j] = v[8 * hf + 4 + j] * rstd * g1[j] + b1[j]; }
        if (o16) *(h8*)(o16 + col) = pack8(y0, y1);
        if (ob16) *(s8v*)(ob16 + col) = pack8b(y0, y1);
        if (o32) { *(f32x4*)(o32 + col) = y0; *(f32x4*)(o32 + col + 4) = y1; }
    }
}
__device__ __forceinline__ void phase_prep(KP P, unsigned char* lds) {
    unsigned char* ws = sopq(GP(P->ws));
    float* tile = (float*)lds;
    const int G = gridDim.x;
    constexpr int J_WIN = 1024, J_SQ = 128, J_GU = 832, J_WD = 352, J_PLE = 32, J_ALL = J_WIN + 3 * J_SQ + J_GU + J_WD + J_PLE;
    for (int j = blockIdx.x; j < J_ALL; j += G) {
        int r = j;
        if (r < J_WIN) { const int rt = r >> 3, kt = r & 7; transpose_job(GP(P->w_in), DIN, map_win(rt * 64), (half_t*)(ws + OFF_WIN), DM, 0, rt * 64, kt * 128, tile, BF_P1); continue; } r -= J_WIN;
        if (r < 3 * J_SQ) { const int w = r >> 7, rr = r & 127, rt = rr >> 3, kt = rr & 7;
            if (w < 2) transpose_job(w == 0 ? GP(P->w_a) : GP(P->w_b), DM, rt * 64, (half_t*)(ws + OFF_WA), YAB, w * DM, rt * 64, kt * 128, tile);
            else transpose_job(GP(P->w_o), DM, rt * 64, (half_t*)(ws + OFF_WO), DM, 0, rt * 64, kt * 128, tile);
            continue; } r -= 3 * J_SQ;
        if (r < J_GU) { const int rt = r >> 3, kt = r & 7, r0 = rt * 64; const float* src; int ld, col;
            if (r0 < 5632) { const int un = r0 >> 8, rho = r0 & 255; ld = DFF; if (rho < 128) { src = GP(P->wg); col = 128 * un + rho; } else { src = GP(P->wu); col = 128 * un + rho - 128; } }
            else { src = GP(P->wpg); ld = DM; col = r0 - 5632; }
            transpose_job(src, ld, col, (half_t*)(ws + OFF_WGU), DM, 0, r0, kt * 128, tile, BF_P9); continue; } r -= J_GU;
        if (r < J_WD) { const int rt = r / 22, kt = r % 22; transpose_job(GP(P->wd), DM, rt * 64, (half_t*)(ws + OFF_WD), HPW, PLE, rt * 64, kt * 128, tile); continue; } r -= J_WD;
        { const int rt = r >> 1, kt = r & 1; transpose_job(GP(P->wple), DM, rt * 64, (half_t*)(ws + OFF_WD), HPW, 0, rt * 64, kt * 128, tile); }
    }
    const int tidp = otid(); const int gt = blockIdx.x * 512 + tidp;
    if (gt < DIN) ((float*)(ws + OFF_BINP))[gt] = GP(P->b_in)[map_win(gt)];
    if (gt < DM) ((float*)(ws + OFF_LB))[gt] = sigm(GP(P->lbl)[gt] - GP(P->lbl)[DM + gt]);
    const int lane = tidp & 63, gw = blockIdx.x * 8 + (tidp >> 6);
    for (int row = gw; row < T; row += 2 * G * 8) {
        const int row2 = row + G * 8;
        const float* x0 = GP(P->x) + (size_t)row * DM; const float* x1 = GP(P->x) + (size_t)(row2 < T ? row2 : row) * DM;
        f32x4 va[4], vb[4]; float sa = 0.f, sb = 0.f;
#pragma unroll
        for (int j = 0; j < 4; ++j) { va[j] = *(const f32x4*)(x0 + 4 * lane + 256 * j); vb[j] = *(const f32x4*)(x1 + 4 * lane + 256 * j); }
#pragma unroll
        for (int j = 0; j < 4; ++j) { sa += (va[j][0] + va[j][1]) + (va[j][2] + va[j][3]); sb += (vb[j][0] + vb[j][1]) + (vb[j][2] + vb[j][3]); }
        const float ma = wave_sum(sa) * (1.f / DM), mb = wave_sum(sb) * (1.f / DM); float qa = 0.f, qb = 0.f;
#pragma unroll
        for (int j = 0; j < 4; ++j) { va[j] = va[j] - ma; vb[j] = vb[j] - mb;
            qa += (va[j][0] * va[j][0] + va[j][1] * va[j][1]) + (va[j][2] * va[j][2] + va[j][3] * va[j][3]);
            qb += (vb[j][0] * vb[j][0] + vb[j][1] * vb[j][1]) + (vb[j][2] * vb[j][2] + vb[j][3] * vb[j][3]); }
        const float ra = 1.f / sqrtf(wave_sum(qa) * (1.f / DM) + 1e-5f), rb = 1.f / sqrtf(wave_sum(qb) * (1.f / DM) + 1e-5f);
        float* st = (float*)(ws + OFF_ST0);
        if (lane == 0) { st[2 * row] = ma; st[2 * row + 1] = ra; if (row2 < T) { st[2 * row2] = mb; st[2 * row2 + 1] = rb; } }
        half_t* o0 = (half_t*)(ws + OFF_S1) + (size_t)row * DM; half_t* o1 = (half_t*)(ws + OFF_S1) + (size_t)row2 * DM;
#pragma unroll
        for (int j = 0; j < 4; ++j) {
            const f32x4 gg = *(const f32x4*)(GP(P->ln0_g) + 4 * lane + 256 * j), bb = *(const f32x4*)(GP(P->ln0_b) + 4 * lane + 256 * j);
            const f32x4 ya = va[j] * ra * gg + bb, yb = vb[j] * rb * gg + bb;
            h4 ha, hb;
#pragma unroll
            for (int k = 0; k < 4; ++k) {
                if (BF_P1) { ha[k] = __builtin_bit_cast(half_t, f2bf(ya[k])); hb[k] = __builtin_bit_cast(half_t, f2bf(yb[k])); }
                else { ha[k] = (half_t)ya[k]; hb[k] = (half_t)yb[k]; }
            }
            *(h4*)(o0 + 4 * lane + 256 * j) = ha;
            if (row2 < T) *(h4*)(o1 + 4 * lane + 256 * j) = hb;
        }
    }
}

__device__ __forceinline__ void gmlp_item(KP P, unsigned char* lds, int item, bool dry = false) {
    unsigned char* ws = sopq(GP(P->ws));
    const int tid = otid(), lane = tid & 63, w = tid >> 6, l15 = lane & 15, quad = lane >> 4;
    const int tok0 = item * 128;
    half_t* U = (half_t*)(ws + OFF_S2); const half_t* V = (const half_t*)(ws + OFF_S7);
    half_t* Ws = (half_t*)lds; half_t* vnT = (half_t*)(lds + 34816); float* mean = (float*)(lds + 69632); float* rstd = mean + 128;
    for (int r4 = 0; r4 < 16; r4 += 4) {
        h8 a[4], b[4];
#pragma unroll
        for (int r = 0; r < 4; ++r) { const half_t* vr = V + (size_t)(tok0 + 16 * w + r4 + r) * DM; a[r] = *(const h8*)(vr + lane * 8); b[r] = *(const h8*)(vr + 512 + lane * 8); }
        asm volatile("" ::: "memory");
#pragma unroll
        for (int r = 0; r < 4; ++r) {
            const int t = 16 * w + r4 + r;
            float s = 0.f, s2 = 0.f;
#pragma unroll
            for (int i = 0; i < 8; ++i) { const float x0 = (float)a[r][i], x1 = (float)b[r][i]; s += x0 + x1; s2 += x0 * x0 + x1 * x1; }
            s = wave_sum(s); s2 = wave_sum(s2);
            const float mu = s * (1.f / DM), var = fmaxf(s2 * (1.f / DM) - mu * mu, 0.f);
            if (lane == 0) { mean[t] = mu; rstd[t] = 1.f / sqrtf(var + 1e-5f); }
        }
    }
    __syncthreads();
    for (int g = 0; g < 8; ++g) {
        f32x4 wvv[8];
#pragma unroll
        for (int i = 0; i < 8; ++i) { const int idx = tid + 512 * i, t = idx >> 5, s4 = idx & 31; wvv[i] = *(const f32x4*)(GP(P->gm_ws) + ((size_t)(g * 128 + t)) * 128 + 4 * s4); }
        h8 vvv[4];
#pragma unroll
        for (int i = 0; i < 4; ++i) { const int idx = i * 8 + w, cc8 = idx & 15, s = (idx >> 4) * 64 + lane; vvv[i] = *(const h8*)(V + (size_t)(tok0 + s) * DM + g * 128 + 8 * cc8); }
        asm volatile("" ::: "memory");
#pragma unroll
        for (int i = 0; i < 8; ++i) {
            const int idx = tid + 512 * i, t = idx >> 5, s4 = idx & 31;
            f32x4 wv = wvv[i];
            if ((t >> 6) < ((4 * s4) >> 6)) wv = (f32x4){0.f, 0.f, 0.f, 0.f};
            h4 hv; hv[0] = (half_t)wv[0]; hv[1] = (half_t)wv[1]; hv[2] = (half_t)wv[2]; hv[3] = (half_t)wv[3];
            *(h4*)(Ws + t * 136 + 4 * s4) = hv;
        }
#pragma unroll
        for (int i = 0; i < 4; ++i) {
            const int idx = i * 8 + w, cc8 = idx & 15, s = (idx >> 4) * 64 + lane;
            const h8 v = vvv[i];
            const float mu = mean[s], rs = rstd[s];
            const f32x4 ga = *(const f32x4*)(GP(P->gm_g) + g * 128 + 8 * cc8), gb = *(const f32x4*)(GP(P->gm_g) + g * 128 + 8 * cc8 + 4);
            const f32x4 ba = *(const f32x4*)(GP(P->gm_b) + g * 128 + 8 * cc8), bb = *(const f32x4*)(GP(P->gm_b) + g * 128 + 8 * cc8 + 4);
#pragma unroll
            for (int k = 0; k < 8; ++k) {
                const float gg = k < 4 ? ga[k & 3] : gb[k & 3], bt = k < 4 ? ba[k & 3] : bb[k & 3];
                vnT[(8 * cc8 + k) * 136 + s] = (half_t)(((float)v[k] - mu) * rs * gg + bt);
            }
        }
        __syncthreads();
        const int nks = w < 4 ? 2 : 4;
        h8 Bf[4];
#pragma unroll
        for (int ks = 0; ks < 4; ++ks) Bf[ks] = *(const h8*)(Ws + (16 * w + l15) * 136 + 32 * ks + 8 * quad);
        const int t = 16 * w + l15;
        const float bias = GP(P->gm_bs)[g * 128 + t];
        h4 uvv[8];
#pragma unroll
        for (int ct = 0; ct < 8; ++ct) uvv[ct] = *(const h4*)(U + (size_t)(tok0 + t) * YAB + g * 128 + 16 * ct + 4 * quad);
#pragma unroll
        for (int ct = 0; ct < 8; ++ct) {
            f32x4 acc = (f32x4){0.f, 0.f, 0.f, 0.f};
#pragma unroll
            for (int ks = 0; ks < 4; ++ks) if (ks < nks) {
                const h8 Af = *(const h8*)(vnT + (16 * ct + l15) * 136 + 32 * ks + 8 * quad);
                acc = __builtin_amdgcn_mfma_f32_16x16x32_f16(Af, Bf[ks], acc, 0, 0, 0);
            }
            half_t* up = U + (size_t)(tok0 + t) * YAB + g * 128 + 16 * ct + 4 * quad;
            const h4 uv = uvv[ct]; h4 y;
#pragma unroll
            for (int j = 0; j < 4; ++j) y[j] = (half_t)((float)uv[j] * (acc[j] + bias));
            if (!dry) *(h4*)up = y;
        }
        __syncthreads();
    }
}

constexpr int HB_QD = 0, HB_QDB = 4352, HB_KDEC = 8704, HB_KET = 13056, HB_VT = 18176, HB_DEC = 23296, HB_OB = 23808, HB_SIZE = 32256;
constexpr int SEGL = 1024, NSEG = 8, NCH = 64, NITEM = 32 * NSEG;

template <bool EMIT>
__device__ __forceinline__ void hgrn_item(KP P, unsigned char* lds, int item, bool dry = false) {
    unsigned char* ws = sopq(GP(P->ws));
    const int tid = otid(), lane = tid & 63, w = tid >> 6, l15 = lane & 15, quad = lane >> 4;
    const int bh = item / NSEG, seg = item % NSEG, b = bh >> 3, h = bh & 7;
    const int tokbase = b * 8192 + seg * SEGL, colbase = h * 128;
    const half_t* Q = (const half_t*)(ws + OFF_S4); const half_t* F = (const half_t*)(ws + OFF_S5); const half_t* I = (const half_t*)(ws + OFF_S6);
    half_t* Gp = (half_t*)(ws + OFF_S2) + DM;
    const float* decay = (const float*)(ws + OFF_DECAY);
    float* Sbuf = (float*)(ws + OFF_S1) + (size_t)item * 16384;
    const int half = tid >> 8, pp = tid & 255, st = pp & 15, sc8 = pp >> 4;
    f32x4 S[8];
#pragma unroll
    for (int dt = 0; dt < 8; ++dt) {
        if (EMIT) {
#pragma unroll
            for (int r = 0; r < 4; ++r) S[dt][r] = Sbuf[((w * 8 + dt) * 4 + r) * 64 + lane];
        } else S[dt] = (f32x4){0.f, 0.f, 0.f, 0.f};
    }
    float dprod = 1.f;
    h8 r0, r1; f32x4 rd0, rd1; h2 gcur[2], gprev[2];
    { const float one = __int_as_float(vopq(0x3f800000)); rd0 = rd1 = (f32x4){one, one, one, one}; const half_t hz = (half_t)__int_as_float(vopq(0)); r1 = r0 = (h8)hz; }
    { const half_t hz = (half_t)__int_as_float(vopq(0)); gcur[0] = gcur[1] = gprev[0] = gprev[1] = (h2)hz; }
    const float og0 = GP(P->hg_g)[colbase + 2 * lane], og1 = GP(P->hg_g)[colbase + 2 * lane + 1];
    {
        const size_t o = (size_t)(tokbase + st) * DM + colbase + 8 * sc8;
        if (half == 0) { r0 = *(const h8*)(Q + o); r1 = *(const h8*)(F + o); const float* dp = decay + (size_t)(tokbase >> 4) * DM + colbase + 8 * sc8; rd0 = *(const f32x4*)dp; rd1 = *(const f32x4*)(dp + 4); }
        else r0 = *(const h8*)(I + o);
    }
#pragma unroll 1
    for (int c = 0; c < NCH; ++c) {
        unsigned char* base = lds + (c & 1) * HB_SIZE;
        if (half == 0) {
            *(h8*)(base + HB_QD + (st * 136 + 8 * sc8) * 2) = r0;
            s8v qb, kb;
#pragma unroll
            for (int i = 0; i < 8; ++i) {
                qb[i] = (short)f2bf((float)r0[i]);
                const float dv = i < 4 ? rd0[i & 3] : rd1[i & 3];
                kb[i] = (short)f2bf((float)r1[i] * __builtin_amdgcn_rcpf(dv));
                *(half_t*)(base + HB_KET + ((8 * sc8 + i) * 20 + st) * 2) = r1[i];
            }
            *(s8v*)(base + HB_QDB + (st * 136 + 8 * sc8) * 2) = qb;
            *(s8v*)(base + HB_KDEC + (st * 136 + 8 * sc8) * 2) = kb;
            if (st == 0) { float* dq = (float*)(base + HB_DEC) + 8 * sc8; *(f32x4*)dq = rd0; *(f32x4*)(dq + 4) = rd1; }
        } else {
#pragma unroll
            for (int i = 0; i < 8; ++i) *(half_t*)(base + HB_VT + ((8 * sc8 + i) * 20 + st) * 2) = r0[i];
        }
        if (EMIT) {
            gprev[0] = gcur[0]; gprev[1] = gcur[1];
#pragma unroll
            for (int tt = 0; tt < 2; ++tt) gcur[tt] = *(const h2*)(Gp + (size_t)(tokbase + c * 16 + 2 * w + tt) * YAB + colbase + 2 * lane);
        }
        if (c + 1 < NCH) {
            const size_t o = (size_t)(tokbase + (c + 1) * 16 + st) * DM + colbase + 8 * sc8;
            if (half == 0) { r0 = *(const h8*)(Q + o); r1 = *(const h8*)(F + o); const float* dp = decay + (size_t)((tokbase >> 4) + c + 1) * DM + colbase + 8 * sc8; rd0 = *(const f32x4*)dp; rd1 = *(const f32x4*)(dp + 4); }
            else r0 = *(const h8*)(I + o);
        }
        __syncthreads();
        if (!EMIT) { if (tid < 128) dprod *= ((const float*)(base + HB_DEC))[tid]; }
        if (EMIT && c >= 1) {
            const float* ob = (const float*)(lds + ((c - 1) & 1) * HB_SIZE + HB_OB);
#pragma unroll
            for (int tt = 0; tt < 2; ++tt) {
                const int t = 2 * w + tt;
                const f32x2 v = *(const f32x2*)(ob + t * 132 + 2 * lane);
                const float ss = wave_sum(v[0] * v[0] + v[1] * v[1]);
                const float rr = 1.f / sqrtf(ss * (1.f / 128.f) + 1e-6f);
                const float g0 = (float)gprev[tt][0], g1 = (float)gprev[tt][1];
                h2 y; y[0] = (half_t)(v[0] * rr * og0 * g0); y[1] = (half_t)(v[1] * rr * og1 * g1);
                if (!dry) *(h2*)(Gp + (size_t)(tokbase + (c - 1) * 16 + t) * YAB + colbase + 2 * lane) = y;
            }
        }
        const h4 vB = *(const h4*)(base + HB_VT + ((16 * w + l15) * 20 + 4 * quad) * 2);
        if (EMIT) {
            f32x4 sc = (f32x4){0.f, 0.f, 0.f, 0.f};
#pragma unroll
            for (int ks = 0; ks < 4; ++ks) {
                const s8v ka = *(const s8v*)(base + HB_KDEC + (l15 * 136 + 32 * ks + 8 * quad) * 2);
                const s8v qb = *(const s8v*)(base + HB_QDB + (l15 * 136 + 32 * ks + 8 * quad) * 2);
                sc = __builtin_amdgcn_mfma_f32_16x16x32_bf16(__builtin_bit_cast(__attribute__((ext_vector_type(8))) __bf16, ka), __builtin_bit_cast(__attribute__((ext_vector_type(8))) __bf16, qb), sc, 0, 0, 0);
            }
            h4 scA;
#pragma unroll
            for (int r = 0; r < 4; ++r) scA[r] = (half_t)((4 * quad + r) <= l15 ? sc[r] : 0.f);
            f32x4 o = __builtin_amdgcn_mfma_f32_16x16x16f16(scA, vB, (f32x4){0.f, 0.f, 0.f, 0.f}, 0, 0, 0); MFMA16_KEEP(scA, vB);
#pragma unroll
            for (int ks = 0; ks < 4; ++ks) {
                const h4 qa = *(const h4*)(base + HB_QD + (l15 * 136 + 32 * ks + 4 * quad) * 2);
                const h4 qc = *(const h4*)(base + HB_QD + (l15 * 136 + 32 * ks + 16 + 4 * quad) * 2);
                h8 qA, sB;
#pragma unroll
                for (int j = 0; j < 4; ++j) { qA[j] = qa[j]; qA[4 + j] = qc[j]; sB[j] = (half_t)S[2 * ks][j]; sB[4 + j] = (half_t)S[2 * ks + 1][j]; }
                o = __builtin_amdgcn_mfma_f32_16x16x32_f16(qA, sB, o, 0, 0, 0);
            }
            float* ob = (float*)(base + HB_OB);
#pragma unroll
            for (int r = 0; r < 4; ++r) ob[(4 * quad + r) * 132 + 16 * w + l15] = o[r];
        }
#pragma unroll
        for (int dt = 0; dt < 8; ++dt) {
            const f32x4 dv = *(const f32x4*)(base + HB_DEC + (16 * dt + 4 * quad) * 4);
            const h4 kA = *(const h4*)(base + HB_KET + ((16 * dt + l15) * 20 + 4 * quad) * 2);
            S[dt] = __builtin_amdgcn_mfma_f32_16x16x16f16(kA, vB, S[dt] * dv, 0, 0, 0); MFMA16_KEEP(kA, vB);
        }
    }
    if (EMIT) {
        __syncthreads();
        const float* ob = (const float*)(lds + ((NCH - 1) & 1) * HB_SIZE + HB_OB);
#pragma unroll
        for (int tt = 0; tt < 2; ++tt) {
            const int t = 2 * w + tt;
            const f32x2 v = *(const f32x2*)(ob + t * 132 + 2 * lane);
            const float ss = wave_sum(v[0] * v[0] + v[1] * v[1]);
            const float rr = 1.f / sqrtf(ss * (1.f / 128.f) + 1e-6f);
            const float g0 = (float)gcur[tt][0], g1 = (float)gcur[tt][1];
            h2 y; y[0] = (half_t)(v[0] * rr * og0 * g0); y[1] = (half_t)(v[1] * rr * og1 * g1);
            if (!dry) *(h2*)(Gp + (size_t)(tokbase + (NCH - 1) * 16 + t) * YAB + colbase + 2 * lane) = y;
        }
    } else {
#pragma unroll
        for (int dt = 0; dt < 8; ++dt)
#pragma unroll
            for (int r = 0; r < 4; ++r) if (!dry) Sbuf[((w * 8 + dt) * 4 + r) * 64 + lane] = S[dt][r];
        if (tid < 128 && !dry) ((float*)(ws + OFF_DSEG))[(size_t)item * 128 + tid] = dprod;
    }
    __syncthreads();
}


__device__ __forceinline__ void hgrn_pairA(KP P, unsigned char* lds, int item0, int item1) {
    unsigned char* ws = sopq(GP(P->ws));
    const int tid = otid(), lane = tid & 63, w = tid >> 6, l15 = lane & 15, quad = lane >> 4;
    const half_t* F = (const half_t*)(ws + OFF_S5); const half_t* I = (const half_t*)(ws + OFF_S6);
    const float* decay = (const float*)(ws + OFF_DECAY);
    const int half = tid >> 8, pp = tid & 255, st = pp & 15, sc8 = pp >> 4;
    int tokbase[2], colbase[2];
#pragma unroll
    for (int j = 0; j < 2; ++j) { const int item = j ? item1 : item0, bh = item / NSEG, seg = item % NSEG; tokbase[j] = (bh >> 3) * 8192 + seg * SEGL; colbase[j] = (bh & 7) * 128; }
    f32x4 S[2][8];
#pragma unroll
    for (int j = 0; j < 2; ++j)
#pragma unroll
        for (int dt = 0; dt < 8; ++dt) S[j][dt] = (f32x4){0.f, 0.f, 0.f, 0.f};
    float dprod[2] = {1.f, 1.f};
    h8 r[2]; f32x4 rd0[2], rd1[2];
    { const float one = __int_as_float(vopq(0x3f800000)); const half_t hz = (half_t)__int_as_float(vopq(0));
#pragma unroll
      for (int j = 0; j < 2; ++j) { rd0[j] = rd1[j] = (f32x4){one, one, one, one}; r[j] = (h8)hz; } }
#pragma unroll
    for (int j = 0; j < 2; ++j) {
        const size_t o = (size_t)(tokbase[j] + st) * DM + colbase[j] + 8 * sc8;
        if (half == 0) { r[j] = *(const h8*)(F + o); const float* dp = decay + (size_t)(tokbase[j] >> 4) * DM + colbase[j] + 8 * sc8; rd0[j] = *(const f32x4*)dp; rd1[j] = *(const f32x4*)(dp + 4); }
        else r[j] = *(const h8*)(I + o);
    }
#pragma unroll 1
    for (int c = 0; c < NCH; ++c) {
#pragma unroll
        for (int j = 0; j < 2; ++j) {
            unsigned char* base = lds + (2 * j + (c & 1)) * HB_SIZE;
            if (half == 0) {
#pragma unroll
                for (int i = 0; i < 8; ++i) *(half_t*)(base + HB_KET + ((8 * sc8 + i) * 20 + st) * 2) = r[j][i];
                if (st == 0) { float* dq = (float*)(base + HB_DEC) + 8 * sc8; *(f32x4*)dq = rd0[j]; *(f32x4*)(dq + 4) = rd1[j]; }
            } else {
#pragma unroll
                for (int i = 0; i < 8; ++i) *(half_t*)(base + HB_VT + ((8 * sc8 + i) * 20 + st) * 2) = r[j][i];
            }
        }
        if (c + 1 < NCH) {
#pragma unroll
            for (int j = 0; j < 2; ++j) {
                const size_t o = (size_t)(tokbase[j] + (c + 1) * 16 + st) * DM + colbase[j] + 8 * sc8;
                if (half == 0) { r[j] = *(const h8*)(F + o); const float* dp = decay + (size_t)((tokbase[j] >> 4) + c + 1) * DM + colbase[j] + 8 * sc8; rd0[j] = *(const f32x4*)dp; rd1[j] = *(const f32x4*)(dp + 4); }
                else r[j] = *(const h8*)(I + o);
            }
        }
        __syncthreads();
#pragma unroll
        for (int j = 0; j < 2; ++j) {
            unsigned char* base = lds + (2 * j + (c & 1)) * HB_SIZE;
            if (tid < 128) dprod[j] *= ((const float*)(base + HB_DEC))[tid];
            const h4 vB = *(const h4*)(base + HB_VT + ((16 * w + l15) * 20 + 4 * quad) * 2);
#pragma unroll
            for (int dt = 0; dt < 8; ++dt) {
                const f32x4 dv = *(const f32x4*)(base + HB_DEC + (16 * dt + 4 * quad) * 4);
                const h4 kA = *(const h4*)(base + HB_KET + ((16 * dt + l15) * 20 + 4 * quad) * 2);
                S[j][dt] = __builtin_amdgcn_mfma_f32_16x16x16f16(kA, vB, S[j][dt] * dv, 0, 0, 0); MFMA16_KEEP(kA, vB);
            }
        }
    }
#pragma unroll
    for (int j = 0; j < 2; ++j) {
        const int item = j ? item1 : item0;
        float* Sbuf = (float*)(ws + OFF_S1) + (size_t)item * 16384;
#pragma unroll
        for (int dt = 0; dt < 8; ++dt)
#pragma unroll
            for (int rr = 0; rr < 4; ++rr) Sbuf[((w * 8 + dt) * 4 + rr) * 64 + lane] = S[j][dt][rr];
        if (tid < 128) ((float*)(ws + OFF_DSEG))[(size_t)item * 128 + tid] = dprod[j];
    }
    __syncthreads();
}

__device__ __forceinline__ void phase_scan(KP P) {
    unsigned char* ws = sopq(GP(P->ws));
    float* Sb = (float*)(ws + OFF_S1); const float* Ds = (const float*)(ws + OFF_DSEG);
    const int N = gridDim.x * 512;
    for (int e4 = blockIdx.x * 512 + otid(); e4 < 32 * 4096; e4 += N) {
        const int bh = e4 >> 12, idx = (e4 & 4095) * 4;
        const int ln = idx & 63, r = (idx >> 6) & 3, dt = (idx >> 8) & 7, d = 16 * dt + 4 * (ln >> 4) + r;
        f32x4 run = (f32x4){0.f, 0.f, 0.f, 0.f};
#pragma unroll 1
        for (int s0 = 0; s0 < NSEG; s0 += 8) {
            f32x4 loc[8]; float dd[8];
#pragma unroll
            for (int k = 0; k < 8; ++k) {
                const int seg = s0 + k;
                if (seg < NSEG - 1) { loc[k] = *(const f32x4*)(Sb + ((size_t)(bh * NSEG + seg)) * 16384 + idx); dd[k] = Ds[(size_t)(bh * NSEG + seg) * 128 + d]; }
                else { loc[k] = (f32x4){0.f, 0.f, 0.f, 0.f}; dd[k] = 0.f; }
            }
            asm volatile("" ::: "memory");
#pragma unroll
            for (int k = 0; k < 8; ++k) {
                const int seg = s0 + k;
                *(f32x4*)(Sb + ((size_t)(bh * NSEG + seg)) * 16384 + idx) = run;
                run = run * dd[k] + loc[k];
            }
            asm volatile("" ::: "memory");
        }
    }
}

__device__ __forceinline__ void phase_ln(KP P, const half_t* src, const float* g, const float* b, half_t* o16, float* o32, unsigned short* ob16 = nullptr) {
    constexpr int NR = 4;
    const int tidl = otid(); const int lane = tidl & 63, gw = blockIdx.x * 8 + (tidl >> 6), stride = gridDim.x * 8;
    for (int row0 = gw; row0 < T; row0 += NR * stride) {
        h8 a[NR], c[NR];
#pragma unroll
        for (int r = 0; r < NR; ++r) { const int row = row0 + r * stride < T ? row0 + r * stride : row0; const half_t* xr = src + (size_t)row * DM; a[r] = *(const h8*)(xr + 8 * lane); c[r] = *(const h8*)(xr + 512 + 8 * lane); }
        asm volatile("" ::: "memory");
#pragma unroll
        for (int r = 0; r < NR; ++r) {
            const int row = row0 + r * stride;
            if (row < T) {
                float v[16]; float s1 = 0.f;
#pragma unroll
                for (int i = 0; i < 8; ++i) { v[i] = (float)a[r][i]; v[8 + i] = (float)c[r][i]; s1 += v[i] + v[8 + i]; }
                const float mean = wave_sum(s1) * (1.f / DM); float s2 = 0.f;
#pragma unroll
                for (int i = 0; i < 16; ++i) { v[i] -= mean; s2 += v[i] * v[i]; }
                const float rstd = 1.f / sqrtf(wave_sum(s2) * (1.f / DM) + 1e-5f);
#pragma unroll
                for (int hf = 0; hf < 2; ++hf) {
                    const int col = 512 * hf + 8 * lane;
                    const f32x4 g0 = *(const f32x4*)(g + col), g1 = *(const f32x4*)(g + col + 4), b0 = *(const f32x4*)(b + col), b1 = *(const f32x4*)(b + col + 4);
                    f32x4 y0, y1;
#pragma unroll
                    for (int j = 0; j < 4; ++j) { y0[j] = v[8 * hf + j] * rstd * g0[j] + b0[j]; y1[j] = v[8 * hf + 4 + j] * rstd * g1[j] + b1[j]; }
                    if (o16) *(h8*)(o16 + (size_t)row * DM + col) = pack8(y0, y1);
                    if (ob16) *(s8v*)(ob16 + (size_t)row * DM + col) = pack8b(y0, y1);
                    if (o32) { *(f32x4*)(o32 + (size_t)row * DM + col) = y0; *(f32x4*)(o32 + (size_t)row * DM + col + 4) = y1; }
                }
            }
        }
    }
}

#define XB_TMO      128
#define XB_XCNT(j)  (256  + 64 * (j))
#define XB_XSUB(j)  (1280 + 64 * (j))
#define XB_XGEN(j)  (2304 + 64 * (j))
#define XB_TOP      3328
#define XB_TOPGEN   3392
#define XCD_BAR_WORDS 3456
#define XB_SPIN_CAP (1u << 18)
__device__ __forceinline__ unsigned xb_ld(unsigned* p)              { return __hip_atomic_load(p, __ATOMIC_RELAXED, __HIP_MEMORY_SCOPE_AGENT); }
__device__ __forceinline__ unsigned xb_add(unsigned* p, unsigned v) { return __hip_atomic_fetch_add(p, v, __ATOMIC_RELAXED, __HIP_MEMORY_SCOPE_AGENT); }
__device__ __forceinline__ unsigned xb_xcc_id() { return (unsigned)__builtin_amdgcn_s_getreg((3 << 11) | 20) & 0xFu; }
#define XB_SPIN(cond, bar) do { unsigned _sp = 0; while (cond) { __builtin_amdgcn_s_sleep(1); \
    if ((++_sp & 255u) == 0u) { if (xb_ld(&(bar)[XB_TMO])) break; if (_sp > XB_SPIN_CAP) { atomicAdd(&(bar)[XB_TMO], 1u); break; } } } } while (0)
struct XcdBarrier { unsigned* bar; unsigned x; volatile LAS unsigned* st; };
__device__ __forceinline__ XcdBarrier xcd_barrier_post(unsigned* bar, volatile LAS unsigned* st) {
    XcdBarrier b; b.bar = bar; b.x = xb_xcc_id(); b.st = st;
    if (otid() == 0) (void)xb_add(&bar[XB_XCNT(b.x)], 1u);
    return b;
}
__device__ __forceinline__ void xcd_barrier_complete(unsigned* bar, unsigned x, unsigned& nloc, unsigned& nx) {
    const unsigned G = gridDim.x * gridDim.y * gridDim.z;
    unsigned sum, cnt, mine, sp = 0u;
    for (;;) {
        sum = 0u; cnt = 0u; mine = 0u;
#pragma unroll
        for (unsigned j = 0; j < 16; ++j) { const unsigned c = xb_ld(&bar[XB_XCNT(j)]); sum += c; cnt += (c > 0u) ? 1u : 0u; mine = (j == x) ? c : mine; }
        if (sum == G) break;
        __builtin_amdgcn_s_sleep(1);
        if ((++sp & 255u) == 0u) { if (xb_ld(&bar[XB_TMO])) break; if (sp > XB_SPIN_CAP) { atomicAdd(&bar[XB_TMO], 1u); break; } }
    }
    nloc = mine > 0u ? mine : 1u; nx = cnt > 0u ? cnt : 1u;
}
__device__ __forceinline__ void xcd_barrier(const XcdBarrier& b) {
    asm volatile("s_waitcnt vmcnt(0)" ::: "memory");
    __syncthreads();
    if (otid() == 0) {
        unsigned* bar = b.bar;
        __builtin_amdgcn_s_waitcnt(0);
        unsigned nloc = b.st[0], nx = b.st[1];
        if (nloc == 0u) { xcd_barrier_complete(bar, b.x, nloc, nx); b.st[0] = nloc; b.st[1] = nx; }
        const unsigned old = xb_add(&bar[XB_XSUB(b.x)], 1u);
        const unsigned gen = old / nloc;
        if (old + 1u == (gen + 1u) * nloc) {
            __builtin_amdgcn_fence(__ATOMIC_RELEASE, "agent");
            asm volatile("s_waitcnt vmcnt(0)" ::: "memory");
            const unsigned og = xb_add(&bar[XB_TOP], 1u);
            const unsigned tg = og / nx;
            if (og + 1u == (tg + 1u) * nx) xb_add(&bar[XB_TOPGEN], 1u);
            else XB_SPIN(xb_ld(&bar[XB_TOPGEN]) == tg, bar);
            __builtin_amdgcn_fence(__ATOMIC_ACQUIRE, "agent");
            xb_add(&bar[XB_XGEN(b.x)], 1u);
            asm volatile("s_waitcnt vmcnt(0)" ::: "memory");
        } else {
            XB_SPIN(xb_ld(&bar[XB_XGEN(b.x)]) == gen, bar);
            __builtin_amdgcn_fence(__ATOMIC_ACQUIRE, "agent");
            asm volatile("s_waitcnt vmcnt(0)" ::: "memory");
        }
    }
    __syncthreads();
}

__global__ void __launch_bounds__(512, 2) mega(Params Pk) {
    KP P = kp_get();
    extern __shared__ __attribute__((aligned(16))) unsigned char shm[];
    cg::grid_group grid = cg::this_grid();
    unsigned char* ws = sopq(GP(P->ws));
    const int G = gridDim.x;
    volatile LAS unsigned* xst = (volatile LAS unsigned*)((LAS unsigned char*)shm + pg8::STAGE_BYTES);
#if USE_XCD
    if (otid() == 0) { xst[0] = 0u; xst[1] = 0u; }
    __syncthreads();
    (void)xcd_barrier_post((unsigned*)(ws + OFF_BAR), xst);
    if (P->ph1 < 0) grid.sync();
#endif
#pragma unroll 1
    for (int pi = P->ph0; pi < P->ph1; ++pi) {
        const int ph = PROG[pi];
        P = kp_get();
        unsigned char* ws = sopq(GP(P->ws));
        int gk = -1, hk = -1, bfk = 0; pg8::Gemm g; g.M = T; g.A = nullptr; g.Bt = nullptr; g.N = DM; g.K = DM;
        switch (ph) {
            case 1: gk = EK_PROJ; bfk = BF_P1; g.A = (const half_t*)(ws + OFF_S1); g.Bt = (const half_t*)(ws + OFF_WIN); g.N = DIN; g.K = DM; break;
            case 5: gk = EK_MRG; hk = 16; g.A = (const half_t*)(ws + OFF_S2); g.Bt = (const half_t*)(ws + OFF_WA); g.K = YAB; break;
            case 7: gk = EK_WO; g.A = (const half_t*)(ws + OFF_S5); g.Bt = (const half_t*)(ws + OFF_WO); break;
            case 9: gk = EK_FFN; bfk = BF_P9; g.A = (const half_t*)(ws + (BF_P9 ? OFF_S4 : OFF_S1)); g.Bt = (const half_t*)(ws + OFF_WGU); g.N = 6656; break;
            case 11: gk = EK_DOWN; hk = 4; g.A = (const half_t*)(ws + OFF_S5); g.Bt = (const half_t*)(ws + OFF_WD); g.K = HPW; break;
            default: break;
        }
        if (gk >= 0) {
            if (gk == EK_PROJ) {
                const int t0 = otid(); const float* bsrc = (const float*)(ws + OFF_BINP); const float* lsrc = (const float*)(ws + OFF_LB);
                LAS half_t* bl = (LAS half_t*)((LAS unsigned char*)shm + LDS_BIAS); LAS float* ll = (LAS float*)((LAS unsigned char*)shm + LDS_LB);
                for (int i = t0; i < DIN; i += 512) bl[i] = (half_t)bsrc[i];
                for (int i = t0; i < DM; i += 512) ll[i] = lsrc[i];
                __syncthreads();
            }
            pg8::StaticOrder S; S.init(g.M, g.N, G, blockIdx.x);
            Epi E; E.kind = gk; E.hook_t = hk; E.P = P; E.lds = (LAS unsigned char*)shm;
            if (bfk) pg8::gemm_phase<Epi, true>((LAS unsigned char*)shm, g, S, E); else pg8::gemm_phase<Epi>((LAS unsigned char*)shm, g, S, E);
        } else if (ph == 0) {
            phase_prep(P, shm);
        } else if (ph == 2) {
            for (int it = blockIdx.x; it < 256; it += G) gmlp_item(P, shm, it);
            for (int it = blockIdx.x; it < NITEM; it += 2 * G) {
                const int it1 = it + G; const bool v0 = (it % NSEG) != NSEG - 1, v1 = it1 < NITEM && (it1 % NSEG) != NSEG - 1;
                if (v0 && v1) hgrn_pairA(P, shm, it, it1);
                else { if (v0) hgrn_item<false>(P, shm, it); if (v1) hgrn_item<false>(P, shm, it1); }
            }
        } else if (ph == 3) {
            phase_scan(P);
        } else if (ph == 4) {
            for (int it = blockIdx.x; it < NITEM; it += G) hgrn_item<true>(P, shm, it);
        } else if (ph == 8) {
            phase_ln(P, (const half_t*)(ws + OFF_S3), GP(P->ln1_g), GP(P->ln1_b), (half_t*)(ws + OFF_S1), nullptr, BF_P9 ? (unsigned short*)(ws + OFF_S4) : nullptr);
            half_t* p16 = (half_t*)(ws + OFF_S5);
            {
                const int i0 = blockIdx.x * 512 + otid(), str = G * 512;
                for (int it = 0; it < 8; it += 4) {
                    f32x4 pa[4], pb[4];
#pragma unroll
                    for (int k = 0; k < 4; ++k) { const int i = i0 + (it + k) * str; const int ic = i < T * PLE / 8 ? i : i0; pa[k] = *(const f32x4*)(GP(P->p) + (size_t)ic * 8); pb[k] = *(const f32x4*)(GP(P->p) + (size_t)ic * 8 + 4); }
                    asm volatile("" ::: "memory");
#pragma unroll
                    for (int k = 0; k < 4; ++k) { const int i = i0 + (it + k) * str; if (i < T * PLE / 8) *(h8*)(p16 + (size_t)(i >> 5) * HPW + (i & 31) * 8) = pack8(pa[k], pb[k]); }
                }
                for (int i = i0 + 8 * str; i < T * PLE / 8; i += str) {
                    const f32x4 a = *(const f32x4*)(GP(P->p) + (size_t)i * 8), b = *(const f32x4*)(GP(P->p) + (size_t)i * 8 + 4);
                    *(h8*)(p16 + (size_t)(i >> 5) * HPW + (i & 31) * 8) = pack8(a, b);
                }
            }
        } else if (ph == 12) {
            phase_ln(P, (const half_t*)(ws + OFF_S3), GP(P->ln2_g), GP(P->ln2_b), nullptr, GP(P->out));
        }
        if (pi + 1 < P->ph1) {
#if USE_XCD
            { XcdBarrier xb; xb.bar = (unsigned*)(ws + OFF_BAR); xb.x = xb_xcc_id(); xb.st = xst; xcd_barrier(xb); }
#else
            grid.sync();
#endif
        }
    }
}

extern "C" void kernel_launch(void* const* d_in, const int* in_sizes, int n_in, void* d_out, int out_size, void* d_ws, size_t ws_size, hipStream_t stream) {
    static int grid = 0;
    constexpr int LDS_BYTES = LDS_TOTAL;
    if (grid == 0) {
        if (n_in != 25 || ws_size < WS_NEED || out_size != T * DM) { fprintf(stderr, "kernel_launch: unexpected shapes n_in %d ws %zu out %d\n", n_in, ws_size, out_size); grid = -1; return; }
        int dev = 0, cus = 0, per_cu = 0;
        hipGetDevice(&dev);
        hipDeviceGetAttribute(&cus, hipDeviceAttributeMultiprocessorCount, dev);
        hipFuncSetAttribute((const void*)mega, hipFuncAttributeMaxDynamicSharedMemorySize, LDS_BYTES);
        hipOccupancyMaxActiveBlocksPerMultiprocessor(&per_cu, (const void*)mega, 512, LDS_BYTES);
        if (per_cu < 1) { fprintf(stderr, "kernel_launch: occupancy query says %d blocks per CU\n", per_cu); per_cu = 1; }
        (void)hipGetLastError();
        grid = cus;
    }
    if (grid < 0) return;
    Params P{};
#if USE_XCD && !MK_MULTI
    (void)hipMemsetAsync((unsigned char*)d_ws + OFF_BAR, 0, XCD_BAR_WORDS * 4, stream);
#endif
    const float** f = (const float**)&P;
    for (int i = 0; i < 25; ++i) f[i] = (const float*)d_in[i];
    P.out = (float*)d_out; P.ws = (unsigned char*)d_ws;
#if MK_MULTI
    for (int ph = 0; ph < NPH; ++ph) {
        P.ph0 = ph; P.ph1 = ph + 1;
        void* args[] = {&P};
        hipError_t e = hipLaunchCooperativeKernel((const void*)mega, dim3(grid), dim3(512), args, LDS_BYTES, stream);
        if (e != hipSuccess) fprintf(stderr, "launch failed: %s\n", hipGetErrorString(e));
    }
#else
    P.ph0 = 0; P.ph1 = NPH;
    void* args[] = {&P};
    hipError_t e = hipLaunchCooperativeKernel((const void*)mega, dim3(grid), dim3(512), args, LDS_BYTES, stream);
    if (e != hipSuccess) fprintf(stderr, "cooperative launch failed: %s (grid %d)\n", hipGetErrorString(e), grid);
#endif
}
```

```cpp
#include <hip/hip_runtime.h>
#include <hip/hip_cooperative_groups.h>
#include <cstdio>
namespace cg = cooperative_groups;

#ifndef BF_P1
#define BF_P1 1
#endif
#ifndef BF_P9
#define BF_P9 1
#endif
#ifndef USE_XCD
#define USE_XCD 1
#endif
#ifndef MK_MULTI
#define MK_MULTI 0
#endif

#define LAS __attribute__((address_space(3)))
typedef _Float16 half_t;
typedef _Float16 h8 __attribute__((ext_vector_type(8)));
typedef _Float16 h4 __attribute__((ext_vector_type(4)));
typedef _Float16 h2 __attribute__((ext_vector_type(2)));
typedef short s8v __attribute__((ext_vector_type(8)));
typedef float f32x4 __attribute__((ext_vector_type(4)));
typedef __bf16 bf8v __attribute__((ext_vector_type(8)));
typedef float f32x2 __attribute__((ext_vector_type(2)));

constexpr int T = 32768, DM = 1024, DIN = 8192, DFF = 2816, PLE = 256, YAB = 2048, HPW = 3072;
constexpr float ALPHA = 1.189207115002721f;
constexpr size_t MiB = (size_t)1 << 20;
constexpr size_t OFF_WIN = 0, OFF_WA = 16 * MiB, OFF_WB = 18 * MiB, OFF_WO = 20 * MiB, OFF_WGU = 22 * MiB, OFF_WD = 35 * MiB, OFF_WPLE = 40 * MiB + 512 * 1024;
constexpr size_t OFF_BINP = 41 * MiB, OFF_LB = 41 * MiB + 32768, OFF_ST0 = 41 * MiB + 65536, OFF_DSEG = 42 * MiB, OFF_DECAY = 43 * MiB;
constexpr size_t OFF_BAR = 52 * MiB;
constexpr size_t OFF_S1 = 64 * MiB, OFF_S2 = 128 * MiB, OFF_S3 = 192 * MiB, OFF_S4 = 256 * MiB, OFF_S5 = 320 * MiB, OFF_S6 = 384 * MiB, OFF_S7 = 448 * MiB, OFF_P16 = 496 * MiB;
constexpr size_t WS_NEED = 512 * MiB;
#ifndef PROG_LIST
#define PROG_LIST 0, 1, 2, 3, 4, 5, 7, 8, 9, 11, 12
#endif
__device__ const int PROG[] = {PROG_LIST};
constexpr int PROG_HOST[] = {PROG_LIST};
constexpr int NPH = sizeof(PROG_HOST) / sizeof(int);

struct Params {
    const float *x, *p, *ln0_g, *ln0_b, *w_in, *b_in, *gm_g, *gm_b, *gm_ws, *gm_bs, *lbl, *hg_g, *w_a, *w_b, *w_o, *ln1_g, *ln1_b, *wg, *wu, *wd, *wple, *wpg, *bpg, *ln2_g, *ln2_b;
    float* out; unsigned char* ws;
    int ph0, ph1;
};

__device__ __forceinline__ int otid() { int t; asm volatile("v_mov_b32 %0, %1" : "=v"(t) : "v"((int)threadIdx.x)); return t; }
__device__ __forceinline__ int vopq(int x) { int t; asm volatile("v_mov_b32 %0, %1" : "=v"(t) : "v"(x)); return t; }
#define GAS __attribute__((address_space(1)))
template <class Tp> __device__ __forceinline__ Tp* GP(Tp* p) { return (Tp*)(Tp GAS*)p; }
typedef const Params __attribute__((address_space(4)))* KP;
__device__ __forceinline__ KP kp_get() { unsigned long long v; asm volatile("s_mov_b64 %0, %1" : "=s"(v) : "s"((unsigned long long)__builtin_amdgcn_kernarg_segment_ptr())); return (KP)v; }
__device__ __forceinline__ unsigned char* sopq(unsigned char* p) { unsigned long long v; asm volatile("s_mov_b64 %0, %1" : "=s"(v) : "s"((unsigned long long)p)); return (unsigned char*)(unsigned char GAS*)v; }
__device__ __forceinline__ float sigm(float x) { return __builtin_amdgcn_rcpf(1.f + __expf(-x)); }
__device__ __forceinline__ float wave_sum(float v) {
#pragma unroll
    for (int o = 1; o < 64; o <<= 1) v += __shfl_xor(v, o);
    return v;
}
__device__ __forceinline__ unsigned short f2bf(float f) { unsigned u = __float_as_uint(f); u += 0x7FFFu + ((u >> 16) & 1u); return (unsigned short)(u >> 16); }
__device__ __forceinline__ h8 pack8(f32x4 a, f32x4 b) { h8 v; v[0] = (half_t)a[0]; v[1] = (half_t)a[1]; v[2] = (half_t)a[2]; v[3] = (half_t)a[3]; v[4] = (half_t)b[0]; v[5] = (half_t)b[1]; v[6] = (half_t)b[2]; v[7] = (half_t)b[3]; return v; }
__device__ __forceinline__ s8v pack8b(f32x4 a, f32x4 b) { s8v v;
#pragma unroll
    for (int i = 0; i < 4; ++i) { v[i] = (short)f2bf(a[i]); v[4 + i] = (short)f2bf(b[i]); }
    return v; }
#define MFMA16_KEEP(a, b) asm volatile("" :: "v"(a), "v"(b))
__device__ __forceinline__ int map_win(int r) {
    if (r < 2048 || (r >= 4096 && r < 6144)) return r;
    const int rho = r & 255;
    if (r >= 6144) { const int j = (r - 6144) >> 8; return rho < 128 ? 6144 + 128 * j + rho : 7168 + 128 * j + rho - 128; }
    const int h = (r - 2048) >> 8;
    return rho < 128 ? 2048 + 128 * h + rho : 3072 + 128 * h + rho - 128;
}

namespace pg8 {
constexpr int BM = 256, BK = 64, HALF = 128, HTB = HALF * BK * 2, STAGE_BYTES = 8 * HTB, NXCD = 8, WGM = 8;
__host__ __device__ __forceinline__ int lds_byte(int r, int c) { const int st = (r >> 4) * 2 + (c >> 5), rr = r & 15, cc = c & 31, ob = rr * 64 + cc * 2; return st * 1024 + (ob ^ (((ob >> 9) & 1) << 5)); }
__host__ __device__ __forceinline__ void stage_rc(int b, int& R, int& C) { const int st = b / 1024, sb = b % 1024, swz = sb ^ (((sb >> 9) & 1) << 5); R = (st >> 1) * 16 + swz / 64; C = (st & 1) * 32 + (swz % 64) / 2; }
__host__ __device__ __forceinline__ int perm32(int rho) { const int n = rho >> 4, i = rho & 15; return 8 * (i >> 2) + 4 * n + (i & 3); }
struct Unit { int pm, pn; };
struct Gemm { const half_t* A; const half_t* Bt; int M, N, K; };
struct StaticOrder {
    int nM, nN, nwg, G, c;
    __host__ __device__ void init(int M, int N, int G_, int c_) { nM = M / BM; nN = N / BM; nwg = nM * nN; G = G_; c = c_; }
    __host__ __device__ bool next(int i, Unit& u) const {
        const long L = (long)i * G + c; if (L >= nwg) return false;
        int wgid = (int)L; { const int q = nwg / NXCD, r = nwg % NXCD, xcd = wgid % NXCD, off = wgid / NXCD; wgid = (xcd < r ? xcd * (q + 1) : r * (q + 1) + (xcd - r) * q) + off; }
        const int nig = WGM * nN, gid = wgid / nig, fm = gid * WGM, gsz = (nM - fm) < WGM ? (nM - fm) : WGM;
        u.pm = fm + ((wgid % nig) % gsz); u.pn = (wgid % nig) / gsz; return true;
    }
};

template <class Epi, bool BF = false>
__device__ __forceinline__ void gemm_phase(LAS unsigned char* lds, const Gemm g, const StaticOrder& S, const Epi& E) {
    const int tid = otid(), wid = __builtin_amdgcn_readfirstlane(tid >> 6), lane = tid & 63, wr = wid >> 2, wc = wid & 3, fr = lane & 15, fq = lane >> 4;
    const int K = g.K, nt = K / BK;
    unsigned voffA[2], voffB[2];
#pragma unroll
    for (int i = 0; i < 2; ++i) { int R, C; stage_rc(tid * 16 + i * 8192, R, C); const int Rb = (R & ~31) + perm32(R & 31);
        voffA[i] = (unsigned)(R * K + C) * 2u; voffB[i] = (unsigned)(Rb * K + C) * 2u; }
    const size_t kstep = (size_t)(BK * 2);
    const size_t hstep = (size_t)HALF * K * 2;
    const size_t tstep = 2 * hstep;
    const unsigned ldsw = (unsigned)wid * 1024u;
    const int aoff = lds_byte(wr * 64 + fr, fq * 8), boff = lds_byte(wc * 32 + fr, fq * 8);
#define PG8_SA(b, h) (((b) * 2 + (h)) * HTB)
#define PG8_SB(b, h) ((4 + (b) * 2 + (h)) * HTB)
#define PG8_STAGE(bufoff, gbase, voff) do { _Pragma("unroll") for (int _i = 0; _i < 2; ++_i) \
        __builtin_amdgcn_global_load_lds((const unsigned*)((const char*)(gbase) + (voff)[_i]), (LAS unsigned*)(lds + (bufoff) + ldsw + _i * 8192), 16, 0, 0); } while (0)
#define PG8_LDA(dst, b, h) do { _Pragma("unroll") for (int m = 0; m < 4; ++m) _Pragma("unroll") for (int k = 0; k < 2; ++k) dst[m][k] = *(const LAS h8*)(lds + PG8_SA(b, h) + aoff + m * 2048 + k * 1024); } while (0)
#define PG8_LDB(dst, b, h) do { _Pragma("unroll") for (int n = 0; n < 2; ++n) _Pragma("unroll") for (int k = 0; k < 2; ++k) dst[n][k] = *(const LAS h8*)(lds + PG8_SB(b, h) + boff + n * 2048 + k * 1024); } while (0)
#define PG8_MMA(ai, bj, At, Bt) do { __builtin_amdgcn_s_setprio(1); _Pragma("unroll") for (int m = 0; m < 4; ++m) _Pragma("unroll") for (int n = 0; n < 2; ++n) _Pragma("unroll") for (int k = 0; k < 2; ++k) \
        acc[ai][bj][m][n] = BF ? __builtin_amdgcn_mfma_f32_16x16x32_bf16(__builtin_bit_cast(bf8v, Bt[n][k]), __builtin_bit_cast(bf8v, At[m][k]), acc[ai][bj][m][n], 0, 0, 0) \
                               : __builtin_amdgcn_mfma_f32_16x16x32_f16(Bt[n][k], At[m][k], acc[ai][bj][m][n], 0, 0, 0); __builtin_amdgcn_s_setprio(0); } while (0)
#define PG8_WAIT_V(n) asm volatile("s_waitcnt vmcnt(" #n ")" ::: "memory")
#define PG8_WAIT_L(n) asm volatile("s_waitcnt lgkmcnt(" #n ")" ::: "memory")
#define PG8_BAR __builtin_amdgcn_s_barrier()
#define PG8_SCHED __builtin_amdgcn_sched_barrier(0)
    Unit cur, nxt; int ui = 0;
    if (!S.next(0, cur)) return;
    f32x4 acc[2][2][4][2];
#pragma unroll
    for (int a = 0; a < 2; ++a)
#pragma unroll
        for (int b = 0; b < 2; ++b)
#pragma unroll
            for (int m = 0; m < 4; ++m)
#pragma unroll
                for (int n = 0; n < 2; ++n) acc[a][b][m][n] = (f32x4){0.f, 0.f, 0.f, 0.f};
    h8 At[4][2], B0[2][2], B1[2][2];
    const char* cA = (const char*)sopq((unsigned char*)g.A) + (size_t)cur.pm * tstep; const char* cB = (const char*)sopq((unsigned char*)g.Bt) + (size_t)cur.pn * tstep;
    PG8_STAGE(PG8_SB(0, 0), cB, voffB); PG8_STAGE(PG8_SA(0, 0), cA, voffA); PG8_STAGE(PG8_SB(0, 1), cB + hstep, voffB); PG8_STAGE(PG8_SA(0, 1), cA + hstep, voffA);
    if (wr == 1) PG8_BAR;
    PG8_WAIT_V(4); PG8_BAR;
    PG8_STAGE(PG8_SB(1, 0), cB + kstep, voffB); PG8_STAGE(PG8_SA(1, 0), cA + kstep, voffA); PG8_STAGE(PG8_SB(1, 1), cB + hstep + kstep, voffB);
    PG8_WAIT_V(6); PG8_BAR;
    for (;;) {
        const bool has_next = S.next(ui + 1, nxt);
        const char* nA = has_next ? (const char*)sopq((unsigned char*)g.A) + (size_t)nxt.pm * tstep : cA; const char* nB = has_next ? (const char*)sopq((unsigned char*)g.Bt) + (size_t)nxt.pn * tstep : cB;
        for (int t = 0; t < nt; t += 2) {
            if (t == E.hook_t) E.mid(acc, cur, wr, wc, fr, fq);
            const bool last = (t == nt - 2);
            const char* a1 = cA + (size_t)(t + 1) * kstep;
            const char* a2 = last ? nA : cA + (size_t)(t + 2) * kstep; const char* b2 = last ? nB : cB + (size_t)(t + 2) * kstep;
            const char* a3 = a2 + kstep; const char* b3 = b2 + kstep;
            PG8_LDB(B0, 0, 0); PG8_SCHED; PG8_LDA(At, 0, 0); PG8_STAGE(PG8_SA(1, 1), a1 + hstep, voffA);
            PG8_WAIT_L(8); PG8_BAR; PG8_WAIT_L(0); PG8_MMA(0, 0, At, B0); PG8_BAR; PG8_SCHED;
            PG8_LDB(B1, 0, 1); PG8_STAGE(PG8_SB(0, 0), b2, voffB);
            PG8_BAR; PG8_WAIT_L(0); PG8_MMA(0, 1, At, B1); PG8_BAR;
            PG8_LDA(At, 0, 1); PG8_STAGE(PG8_SA(0, 0), a2, voffA);
            PG8_BAR; PG8_WAIT_L(0); PG8_MMA(1, 0, At, B0); PG8_BAR; PG8_SCHED;
            PG8_STAGE(PG8_SB(0, 1), b2 + hstep, voffB);
            PG8_WAIT_V(6); PG8_BAR; PG8_MMA(1, 1, At, B1); PG8_BAR;
            PG8_LDB(B0, 1, 0); PG8_SCHED; PG8_LDA(At, 1, 0); PG8_STAGE(PG8_SA(0, 1), a2 + hstep, voffA);
            PG8_WAIT_L(8); PG8_BAR; PG8_WAIT_L(0); PG8_MMA(0, 0, At, B0); PG8_BAR; PG8_SCHED;
            PG8_LDB(B1, 1, 1); PG8_STAGE(PG8_SB(1, 0), b3, voffB);
            PG8_BAR; PG8_WAIT_L(0); PG8_MMA(0, 1, At, B1); PG8_BAR;
            PG8_LDA(At, 1, 1); PG8_STAGE(PG8_SA(1, 0), a3, voffA);
            PG8_BAR; PG8_WAIT_L(0); PG8_MMA(1, 0, At, B0); PG8_BAR; PG8_SCHED;
            PG8_STAGE(PG8_SB(1, 1), b3 + hstep, voffB);
            PG8_WAIT_V(6); PG8_BAR; PG8_MMA(1, 1, At, B1); PG8_BAR;
        }
        E(acc, cur, wr, wc, fr, fq);
        if (!has_next) break;
#pragma unroll
        for (int a = 0; a < 2; ++a)
#pragma unroll
            for (int b = 0; b < 2; ++b)
#pragma unroll
                for (int m = 0; m < 4; ++m)
#pragma unroll
                    for (int n = 0; n < 2; ++n) acc[a][b][m][n] = (f32x4){0.f, 0.f, 0.f, 0.f};
        cur = nxt; cA = nA; cB = nB; ++ui;
    }
    PG8_WAIT_V(0);
    if (wr == 0) PG8_BAR;
    PG8_BAR;
#undef PG8_SA
#undef PG8_SB
#undef PG8_STAGE
#undef PG8_LDA
#undef PG8_LDB
#undef PG8_MMA
#undef PG8_WAIT_V
#undef PG8_WAIT_L
#undef PG8_BAR
#undef PG8_SCHED
}
}

enum { EK_PROJ = 0, EK_MRG, EK_WO, EK_FFN, EK_DOWN, EK_NONE };

__device__ __forceinline__ float dpp_shr_add(float v, int) { return v; }
template <int CTRL> __device__ __forceinline__ float dpp_shr(float v) {
    return __builtin_bit_cast(float, __builtin_amdgcn_update_dpp(0, __builtin_bit_cast(int, v), CTRL, 0xf, 0xf, true));
}
__device__ __forceinline__ float row_scan16(float v) {
    v += dpp_shr<0x111>(v); v += dpp_shr<0x112>(v); v += dpp_shr<0x114>(v); v += dpp_shr<0x118>(v); return v;
}

template <int CTRL> __device__ __forceinline__ float dpp_shr1(float v) {
    return __builtin_bit_cast(float, __builtin_amdgcn_update_dpp(0x3f800000, __builtin_bit_cast(int, v), CTRL, 0xf, 0xf, false));
}
__device__ __forceinline__ float row_scanmul16(float v) {
    v *= dpp_shr1<0x111>(v); v *= dpp_shr1<0x112>(v); v *= dpp_shr1<0x114>(v); v *= dpp_shr1<0x118>(v); return v;
}
constexpr int LDS_BIAS = pg8::STAGE_BYTES + 16, LDS_LB = LDS_BIAS + DIN * 2, LDS_TOTAL = LDS_LB + DM * 4;
__device__ __forceinline__ f32x4 ldb4(const LAS half_t* p, int i) { const h4 v = *(const LAS h4*)(p + i); return (f32x4){(float)v[0], (float)v[1], (float)v[2], (float)v[3]}; }
struct Epi {
    int kind, hook_t;
    KP P;
    LAS unsigned char* lds;
    __device__ __forceinline__ void mid(f32x4 (&acc)[2][2][4][2], const pg8::Unit& u, int wr, int wc, int fr, int fq) const {
        unsigned char* ws = sopq(GP(P->ws));
        const int tid_ = otid(), lane_ = tid_ & 63, wid_ = tid_ >> 6;
        const int rowb = u.pm * 256 + (wid_ >> 2) * 64 + (lane_ & 15);
        const int c8 = (wid_ & 3) * 32 + (lane_ >> 4) * 8;
        const half_t* gsrc = kind == EK_MRG ? (const half_t*)GP(P->out) : (const half_t*)(ws + OFF_S2);
#pragma unroll
        for (int ai = 0; ai < 2; ++ai) {
            h8 gv[4][2];
#pragma unroll
            for (int m = 0; m < 4; ++m)
#pragma unroll
                for (int bj = 0; bj < 2; ++bj) gv[m][bj] = *(const h8*)(gsrc + (size_t)(rowb + ai * 128 + m * 16) * DM + u.pn * 256 + 128 * bj + c8);
            asm volatile("" ::: "memory");
#pragma unroll
            for (int m = 0; m < 4; ++m)
#pragma unroll
                for (int bj = 0; bj < 2; ++bj)
#pragma unroll
                    for (int j = 0; j < 4; ++j) { acc[ai][bj][m][0][j] *= (float)gv[m][bj][j]; acc[ai][bj][m][1][j] *= (float)gv[m][bj][4 + j]; }
            asm volatile("" ::: "memory");
        }
    }
    __device__ __forceinline__ void operator()(const f32x4 (&acc)[2][2][4][2], const pg8::Unit& u, int, int, int fr, int) const {
        unsigned char* ws = sopq(GP(P->ws));
        const int tid_ = otid(), lane = tid_ & 63, wid_ = tid_ >> 6;
        const int rowb = u.pm * 256 + (wid_ >> 2) * 64 + (lane & 15);
        const int c8 = (wid_ & 3) * 32 + (lane >> 4) * 8;
        fr = lane & 15;
        if (kind == EK_PROJ) {
            const LAS half_t* binp = (const LAS half_t*)(lds + LDS_BIAS);
            const int pn = u.pn;
            if (pn >= 8 && pn < 16) {
                const int h = pn - 8;
                half_t* Q = (half_t*)(ws + OFF_S4); half_t* F = (half_t*)(ws + OFF_S5); float* decay = (float*)(ws + OFF_DECAY);
                const LAS float* lbp = (const LAS float*)(lds + LDS_LB) + 128 * h + c8;
                const f32x4 lb0 = *(const LAS f32x4*)lbp, lb1 = *(const LAS f32x4*)(lbp + 4);
                const f32x4 bq0 = ldb4(binp, 256 * pn + c8), bq1 = ldb4(binp, 256 * pn + c8 + 4);
                const f32x4 bf0 = ldb4(binp, 256 * pn + 128 + c8), bf1 = ldb4(binp, 256 * pn + 128 + c8 + 4);
                const int src_last = ((lane | 15) << 2);
#pragma unroll
                for (int ai = 0; ai < 2; ++ai)
#pragma unroll
                    for (int m = 0; m < 4; ++m) {
                        const int row = rowb + ai * 128 + m * 16;
                        f32x4 qd[2], ke[2], dc[2];
#pragma unroll
                        for (int n = 0; n < 2; ++n)
#pragma unroll
                            for (int j = 0; j < 4; ++j) {
                                const float lb = n ? lb1[j] : lb0[j];
                                const float qv = acc[ai][0][m][n][j] + (n ? bq1[j] : bq0[j]);
                                const float fv = acc[ai][1][m][n][j] + (n ? bf1[j] : bf0[j]);
                                const float ef = __expf(-fv), sg = __builtin_amdgcn_rcpf(1.f + ef);
                                const float oml = 1.f - lb;
                                const float kk = oml * ef * sg;
                                const float pr = row_scanmul16(lb + oml * sg);
                                const float pl = __builtin_bit_cast(float, __builtin_amdgcn_ds_bpermute(src_last, __builtin_bit_cast(int, pr)));
                                qd[n][j] = qv * sigm(qv) * pr;
                                ke[n][j] = kk * pl * __builtin_amdgcn_rcpf(pr);
                                dc[n][j] = pl;
                            }
                        const size_t o = (size_t)row * DM + 128 * h + c8;
                        *(h8*)(Q + o) = pack8(qd[0], qd[1]);
                        *(h8*)(F + o) = pack8(ke[0], ke[1]);
                        if (fr == 15) { float* dp = decay + (size_t)(row >> 4) * DM + 128 * h + c8; *(f32x4*)dp = dc[0]; *(f32x4*)(dp + 4) = dc[1]; }
                    }
            } else if (pn >= 24) {
                const int j = pn - 24;
                half_t* R = (half_t*)GP(P->out); half_t* SB = (half_t*)GP(P->out) + (size_t)T * DM;
                const f32x4 ba0 = ldb4(binp, 256 * pn + c8), ba1 = ldb4(binp, 256 * pn + c8 + 4);
                const f32x4 bb0 = ldb4(binp, 256 * pn + 128 + c8), bb1 = ldb4(binp, 256 * pn + 128 + c8 + 4);
#pragma unroll
                for (int ai = 0; ai < 2; ++ai)
#pragma unroll
                    for (int m = 0; m < 4; ++m) {
                        const int row = rowb + ai * 128 + m * 16;
                        f32x4 rr[2], sb[2];
#pragma unroll
                        for (int n = 0; n < 2; ++n)
#pragma unroll
                            for (int jj = 0; jj < 4; ++jj) {
                                const float ea = __expf(-(acc[ai][0][m][n][jj] + (n ? ba1[jj] : ba0[jj]))), eb = __expf(-(acc[ai][1][m][n][jj] + (n ? bb1[jj] : bb0[jj])));
                                sb[n][jj] = __builtin_amdgcn_rcpf(1.f + eb);
                                rr[n][jj] = fminf((1.f + eb) * __builtin_amdgcn_rcpf(1.f + ea), 60000.f);
                            }
                        const size_t o = (size_t)row * DM + 128 * j + c8;
                        *(h8*)(R + o) = pack8(rr[0], rr[1]);
                        *(h8*)(SB + o) = pack8(sb[0], sb[1]);
                    }
            } else {
                half_t* dst; int act, colt;
                int ldd = DM;
                if (pn < 4) { dst = (half_t*)(ws + OFF_S2); act = 0; colt = pn * 256; ldd = YAB; }
                else if (pn < 8) { dst = (half_t*)(ws + OFF_S7); act = 0; colt = (pn - 4) * 256; }
                else if (pn < 20) { dst = (half_t*)(ws + OFF_S6); act = 1; colt = (pn - 16) * 256; }

                else { dst = (half_t*)(ws + OFF_S2) + DM; act = 2; colt = (pn - 20) * 256; ldd = YAB; }
#pragma unroll
                for (int bj = 0; bj < 2; ++bj) {
                    const f32x4 b0 = ldb4(binp, 256 * pn + 128 * bj + c8), b1 = ldb4(binp, 256 * pn + 128 * bj + c8 + 4);
#pragma unroll
                    for (int ai = 0; ai < 2; ++ai)
#pragma unroll
                        for (int m = 0; m < 4; ++m) {
                            const int row = rowb + ai * 128 + m * 16;
                            f32x4 r[2];
#pragma unroll
                            for (int n = 0; n < 2; ++n)
#pragma unroll
                                for (int j = 0; j < 4; ++j) {
                                    const float v = acc[ai][bj][m][n][j] + (n ? b1[j] : b0[j]);
                                    const float arg = act == 0 ? 1.5957691216057308f * (v + 0.044715f * v * v * v) : v;
                                    const float s = sigm(arg);
                                    r[n][j] = act == 1 ? v : (act == 3 ? s : v * s);
                                }
                            *(h8*)(dst + (size_t)row * ldd + colt + 128 * bj + c8) = pack8(r[0], r[1]);
                        }
                }
            }
        } else if (kind == EK_MRG) {
            const half_t* gate = (const half_t*)GP(P->out) + (size_t)T * DM;
            half_t* merged = (half_t*)(ws + OFF_S5);
#pragma unroll
            for (int ai = 0; ai < 2; ++ai) {
                h8 gv[4][2];
#pragma unroll
                for (int m = 0; m < 4; ++m)
#pragma unroll
                    for (int bj = 0; bj < 2; ++bj) gv[m][bj] = *(const h8*)(gate + (size_t)(rowb + ai * 128 + m * 16) * DM + u.pn * 256 + 128 * bj + c8);
                asm volatile("" ::: "memory");
#pragma unroll
                for (int m = 0; m < 4; ++m)
#pragma unroll
                    for (int bj = 0; bj < 2; ++bj) {
                        const size_t o = (size_t)(rowb + ai * 128 + m * 16) * DM + u.pn * 256 + 128 * bj + c8;
                        f32x4 r0, r1;
#pragma unroll
                        for (int j = 0; j < 4; ++j) { r0[j] = (float)gv[m][bj][j] * acc[ai][bj][m][0][j]; r1[j] = (float)gv[m][bj][4 + j] * acc[ai][bj][m][1][j]; }
                        *(h8*)(merged + o) = pack8(r0, r1);
                    }
                asm volatile("" ::: "memory");
            }
        } else if (kind == EK_WO) {
            half_t* z1 = (half_t*)(ws + OFF_S3);
            const float* st0 = (const float*)(ws + OFF_ST0);
            f32x4 g0[2], g1[2], b0[2], b1[2];
#pragma unroll
            for (int bj = 0; bj < 2; ++bj) { const int col = u.pn * 256 + 128 * bj + c8;
                g0[bj] = *(const f32x4*)(GP(P->ln0_g) + col); g1[bj] = *(const f32x4*)(GP(P->ln0_g) + col + 4); b0[bj] = *(const f32x4*)(GP(P->ln0_b) + col); b1[bj] = *(const f32x4*)(GP(P->ln0_b) + col + 4); }
#pragma unroll
            for (int ai = 0; ai < 2; ++ai)
#pragma unroll
                for (int mh = 0; mh < 2; ++mh) {
                    f32x2 ms[2]; f32x4 x0[2][2], x1[2][2];
#pragma unroll
                    for (int mm = 0; mm < 2; ++mm) { const int row = rowb + ai * 128 + (2 * mh + mm) * 16;
                        ms[mm] = *(const f32x2*)(st0 + 2 * row);
#pragma unroll
                        for (int bj = 0; bj < 2; ++bj) { const size_t o = (size_t)row * DM + u.pn * 256 + 128 * bj + c8; x0[mm][bj] = *(const f32x4*)(GP(P->x) + o); x1[mm][bj] = *(const f32x4*)(GP(P->x) + o + 4); } }
                    asm volatile("" ::: "memory");
#pragma unroll
                    for (int mm = 0; mm < 2; ++mm)
#pragma unroll
                        for (int bj = 0; bj < 2; ++bj) { const int m = 2 * mh + mm; const size_t o = (size_t)(rowb + ai * 128 + m * 16) * DM + u.pn * 256 + 128 * bj + c8;
                            f32x4 r0, r1;
#pragma unroll
                            for (int j = 0; j < 4; ++j) {
                                r0[j] = ALPHA * ((x0[mm][bj][j] - ms[mm][0]) * ms[mm][1] * g0[bj][j] + b0[bj][j]) + acc[ai][bj][m][0][j];
                                r1[j] = ALPHA * ((x1[mm][bj][j] - ms[mm][0]) * ms[mm][1] * g1[bj][j] + b1[bj][j]) + acc[ai][bj][m][1][j];
                            }
                            *(h8*)(z1 + o) = pack8(r0, r1); }
                    asm volatile("" ::: "memory");
                }
        } else if (kind == EK_FFN) {
            if (u.pn < 22) {
                half_t* hid = (half_t*)(ws + OFF_S5);
#pragma unroll
                for (int ai = 0; ai < 2; ++ai)
#pragma unroll
                    for (int m = 0; m < 4; ++m) {
                        const int row = rowb + ai * 128 + m * 16;
                        f32x4 r[2];
#pragma unroll
                        for (int n = 0; n < 2; ++n)
#pragma unroll
                            for (int j = 0; j < 4; ++j) { const float gt = acc[ai][0][m][n][j]; r[n][j] = gt * sigm(gt) * acc[ai][1][m][n][j]; }
                        *(h8*)(hid + (size_t)row * HPW + PLE + 128 * u.pn + c8) = pack8(r[0], r[1]);
                    }
            } else {
                half_t* pg = (half_t*)(ws + OFF_S2);
#pragma unroll
                for (int bj = 0; bj < 2; ++bj) {
                    const int col = (u.pn - 22) * 256 + 128 * bj + c8;
                    const f32x4 b0 = *(const f32x4*)(GP(P->bpg) + col), b1 = *(const f32x4*)(GP(P->bpg) + col + 4);
#pragma unroll
                    for (int ai = 0; ai < 2; ++ai)
#pragma unroll
                        for (int m = 0; m < 4; ++m) {
                            const int row = rowb + ai * 128 + m * 16;
                            f32x4 r[2];
#pragma unroll
                            for (int n = 0; n < 2; ++n)
#pragma unroll
                                for (int j = 0; j < 4; ++j) r[n][j] = sigm(acc[ai][bj][m][n][j] + (n ? b1[j] : b0[j]));
                            *(h8*)(pg + (size_t)row * DM + col) = pack8(r[0], r[1]);
                        }
                }
            }
        } else if (kind == EK_DOWN) {
            const half_t* h1 = (const half_t*)(ws + OFF_S1);
            half_t* z2 = (half_t*)(ws + OFF_S3);
#pragma unroll
            for (int ai = 0; ai < 2; ++ai) {
                h8 hv[4][2];
#pragma unroll
                for (int m = 0; m < 4; ++m)
#pragma unroll
                    for (int bj = 0; bj < 2; ++bj) hv[m][bj] = *(const h8*)(h1 + (size_t)(rowb + ai * 128 + m * 16) * DM + u.pn * 256 + 128 * bj + c8);
                asm volatile("" ::: "memory");
#pragma unroll
                for (int m = 0; m < 4; ++m)
#pragma unroll
                    for (int bj = 0; bj < 2; ++bj) {
                        const size_t o = (size_t)(rowb + ai * 128 + m * 16) * DM + u.pn * 256 + 128 * bj + c8;
                        f32x4 r0, r1;
#pragma unroll
                        for (int j = 0; j < 4; ++j) { r0[j] = acc[ai][bj][m][0][j] + ALPHA * (float)hv[m][bj][j]; r1[j] = acc[ai][bj][m][1][j] + ALPHA * (float)hv[m][bj][4 + j]; }
                        *(h8*)(z2 + o) = pack8(r0, r1);
                    }
                asm volatile("" ::: "memory");
            }
        }
    }
};

__device__ __forceinline__ void transpose_job(const float* src, int ld, int col0, half_t* dst, int dld, int dk0, int r0, int k0, float* tile, bool bf = false) {
    const int tid = otid();
    f32x4 tv[4];
#pragma unroll
    for (int i = 0; i < 4; ++i) { const int idx = tid + 512 * i, k = idx >> 4, n4 = idx & 15; tv[i] = *(const f32x4*)(src + (size_t)(k0 + k) * ld + col0 + 4 * n4); }
    asm volatile("" ::: "memory");
#pragma unroll
    for (int i = 0; i < 4; ++i) { const int idx = tid + 512 * i, k = idx >> 4, n4 = idx & 15; *(f32x4*)(tile + k * 68 + 4 * n4) = tv[i]; }
    __syncthreads();
#pragma unroll
    for (int i = 0; i < 2; ++i) { const int idx = tid + 512 * i, n = idx & 63, k8 = idx >> 6; h8 v; s8v vb;
#pragma unroll
        for (int j = 0; j < 8; ++j) { const float t = tile[(8 * k8 + j) * 68 + n]; v[j] = (half_t)t; vb[j] = (short)f2bf(t); }
        if (bf) *(s8v*)(dst + (size_t)(r0 + n) * dld + dk0 + k0 + 8 * k8) = vb; else *(h8*)(dst + (size_t)(r0 + n) * dld + dk0 + k0 + 8 * k8) = v; }
    __syncthreads();
}
__device__ __forceinline__ void ln_row(const float* xr, const float* g, const float* b, half_t* o16, float* o32, float* stat, int lane) {
    f32x4 v[4]; float s = 0.f;
#pragma unroll
    for (int j = 0; j < 4; ++j) { v[j] = *(const f32x4*)(xr + 4 * lane + 256 * j); s += (v[j][0] + v[j][1]) + (v[j][2] + v[j][3]); }
    const float mean = wave_sum(s) * (1.f / DM); float s2 = 0.f;
#pragma unroll
    for (int j = 0; j < 4; ++j) { v[j] = v[j] - mean; s2 += (v[j][0] * v[j][0] + v[j][1] * v[j][1]) + (v[j][2] * v[j][2] + v[j][3] * v[j][3]); }
    const float rstd = 1.f / sqrtf(wave_sum(s2) * (1.f / DM) + 1e-5f);
    if (stat && lane == 0) { stat[0] = mean; stat[1] = rstd; }
#pragma unroll
    for (int j = 0; j < 4; ++j) {
        const f32x4 gg = *(const f32x4*)(g + 4 * lane + 256 * j), bb = *(const f32x4*)(b + 4 * lane + 256 * j);
        const f32x4 y = v[j] * rstd * gg + bb;
        if (o16) { h4 hv; hv[0] = (half_t)y[0]; hv[1] = (half_t)y[1]; hv[2] = (half_t)y[2]; hv[3] = (half_t)y[3]; *(h4*)(o16 + 4 * lane + 256 * j) = hv; }
        if (o32) *(f32x4*)(o32 + 4 * lane + 256 * j) = y;
    }
}
__device__ __forceinline__ void ln_row16(const half_t* xr, const float* g, const float* b, half_t* o16, float* o32, int lane, unsigned short* ob16 = nullptr) {
    const h8 a = *(const h8*)(xr + 8 * lane), c = *(const h8*)(xr + 512 + 8 * lane);
    float v[16]; float s = 0.f;
#pragma unroll
    for (int i = 0; i < 8; ++i) { v[i] = (float)a[i]; v[8 + i] = (float)c[i]; s += v[i] + v[8 + i]; }
    const float mean = wave_sum(s) * (1.f / DM); float s2 = 0.f;
#pragma unroll
    for (int i = 0; i < 16; ++i) { v[i] -= mean; s2 += v[i] * v[i]; }
    const float rstd = 1.f / sqrtf(wave_sum(s2) * (1.f / DM) + 1e-5f);
#pragma unroll
    for (int hf = 0; hf < 2; ++hf) {
        const int col = 512 * hf + 8 * lane;
        const f32x4 g0 = *(const f32x4*)(g + col), g1 = *(const f32x4*)(g + col + 4), b0 = *(const f32x4*)(b + col), b1 = *(const f32x4*)(b + col + 4);
        f32x4 y0, y1;
#pragma unroll
        for (int j = 0; j < 4; ++j) { y0[j] = v[8 * hf + j] * rstd * g0[j] + b0[j]; y1[j] = v[8 * hf + 4 + j] * rstd * g1[j] + b1[j]; }
        if (o16) *(h8*)(o16 + col) = pack8(y0, y1);
        if (ob16) *(s8v*)(ob16 + col) = pack8b(y0, y1);
        if (o32) { *(f32x4*)(o32 + col) = y0; *(f32x4*)(o32 + col + 4) = y1; }
    }
}
__device__ __forceinline__ void phase_prep(KP P, unsigned char* lds) {
    unsigned char* ws = sopq(GP(P->ws));
    float* tile = (float*)lds;
    const int G = gridDim.x;
    constexpr int J_WIN = 1024, J_SQ = 128, J_GU = 832, J_WD = 352, J_PLE = 32, J_ALL = J_WIN + 3 * J_SQ + J_GU + J_WD + J_PLE;
    for (int j = blockIdx.x; j < J_ALL; j += G) {
        int r = j;
        if (r < J_WIN) { const int rt = r >> 3, kt = r & 7; transpose_job(GP(P->w_in), DIN, map_win(rt * 64), (half_t*)(ws + OFF_WIN), DM, 0, rt * 64, kt * 128, tile, BF_P1); continue; } r -= J_WIN;
        if (r < 3 * J_SQ) { const int w = r >> 7, rr = r & 127, rt = rr >> 3, kt = rr & 7;
            if (w < 2) transpose_job(w == 0 ? GP(P->w_a) : GP(P->w_b), DM, rt * 64, (half_t*)(ws + OFF_WA), YAB, w * DM, rt * 64, kt * 128, tile);
            else transpose_job(GP(P->w_o), DM, rt * 64, (half_t*)(ws + OFF_WO), DM, 0, rt * 64, kt * 128, tile);
            continue; } r -= 3 * J_SQ;
        if (r < J_GU) { const int rt = r >> 3, kt = r & 7, r0 = rt * 64; const float* src; int ld, col;
            if (r0 < 5632) { const int un = r0 >> 8, rho = r0 & 255; ld = DFF; if (rho < 128) { src = GP(P->wg); col = 128 * un + rho; } else { src = GP(P->wu); col = 128 * un + rho - 128; } }
            else { src = GP(P->wpg); ld = DM; col = r0 - 5632; }
            transpose_job(src, ld, col, (half_t*)(ws + OFF_WGU), DM, 0, r0, kt * 128, tile, BF_P9); continue; } r -= J_GU;
        if (r < J_WD) { const int rt = r / 22, kt = r % 22; transpose_job(GP(P->wd), DM, rt * 64, (half_t*)(ws + OFF_WD), HPW, PLE, rt * 64, kt * 128, tile); continue; } r -= J_WD;
        { const int rt = r >> 1, kt = r & 1; transpose_job(GP(P->wple), DM, rt * 64, (half_t*)(ws + OFF_WD), HPW, 0, rt * 64, kt * 128, tile); }
    }
    const int tidp = otid(); const int gt = blockIdx.x * 512 + tidp;
    if (gt < DIN) ((float*)(ws + OFF_BINP))[gt] = GP(P->b_in)[map_win(gt)];
    if (gt < DM) ((float*)(ws + OFF_LB))[gt] = sigm(GP(P->lbl)[gt] - GP(P->lbl)[DM + gt]);
    const int lane = tidp & 63, gw = blockIdx.x * 8 + (tidp >> 6);
    for (int row = gw; row < T; row += 2 * G * 8) {
        const int row2 = row + G * 8;
        const float* x0 = GP(P->x) + (size_t)row * DM; const float* x1 = GP(P->x) + (size_t)(row2 < T ? row2 : row) * DM;
        f32x4 va[4], vb[4]; float sa = 0.f, sb = 0.f;
#pragma unroll
        for (int j = 0; j < 4; ++j) { va[j] = __builtin_nontemporal_load((const f32x4*)(x0 + 4 * lane + 256 * j)); vb[j] = __builtin_nontemporal_load((const f32x4*)(x1 + 4 * lane + 256 * j)); }
#pragma unroll
        for (int j = 0; j < 4; ++j) { sa += (va[j][0] + va[j][1]) + (va[j][2] + va[j][3]); sb += (vb[j][0] + vb[j][1]) + (vb[j][2] + vb[j][3]); }
        const float ma = wave_sum(sa) * (1.f / DM), mb = wave_sum(sb) * (1.f / DM); float qa = 0.f, qb = 0.f;
#pragma unroll
        for (int j = 0; j < 4; ++j) { va[j] = va[j] - ma; vb[j] = vb[j] - mb;
            qa += (va[j][0] * va[j][0] + va[j][1] * va[j][1]) + (va[j][2] * va[j][2] + va[j][3] * va[j][3]);
            qb += (vb[j][0] * vb[j][0] + vb[j][1] * vb[j][1]) + (vb[j][2] * vb[j][2] + vb[j][3] * vb[j][3]); }
        const float ra = 1.f / sqrtf(wave_sum(qa) * (1.f / DM) + 1e-5f), rb = 1.f / sqrtf(wave_sum(qb) * (1.f / DM) + 1e-5f);
        float* st = (float*)(ws + OFF_ST0);
        if (lane == 0) { st[2 * row] = ma; st[2 * row + 1] = ra; if (row2 < T) { st[2 * row2] = mb; st[2 * row2 + 1] = rb; } }
        half_t* o0 = (half_t*)(ws + OFF_S1) + (size_t)row * DM; half_t* o1 = (half_t*)(ws + OFF_S1) + (size_t)row2 * DM;
#pragma unroll
        for (int j = 0; j < 4; ++j) {
            const f32x4 gg = *(const f32x4*)(GP(P->ln0_g) + 4 * lane + 256 * j), bb = *(const f32x4*)(GP(P->ln0_b) + 4 * lane + 256 * j);
            const f32x4 ya = va[j] * ra * gg + bb, yb = vb[j] * rb * gg + bb;
            h4 ha, hb;
#pragma unroll
            for (int k = 0; k < 4; ++k) {
                if (BF_P1) { ha[k] = __builtin_bit_cast(half_t, f2bf(ya[k])); hb[k] = __builtin_bit_cast(half_t, f2bf(yb[k])); }
                else { ha[k] = (half_t)ya[k]; hb[k] = (half_t)yb[k]; }
            }
            *(h4*)(o0 + 4 * lane + 256 * j) = ha;
            if (row2 < T) *(h4*)(o1 + 4 * lane + 256 * j) = hb;
        }
    }
}

__device__ __forceinline__ void gmlp_item(KP P, unsigned char* lds, int item, bool dry = false) {
    unsigned char* ws = sopq(GP(P->ws));
    const int tid = otid(), lane = tid & 63, w = tid >> 6, l15 = lane & 15, quad = lane >> 4;
    const int tok0 = item * 128;
    half_t* U = (half_t*)(ws + OFF_S2); const half_t* V = (const half_t*)(ws + OFF_S7);
    half_t* Ws = (half_t*)lds; half_t* vnT = (half_t*)(lds + 34816); float* mean = (float*)(lds + 69632); float* rstd = mean + 128;
    for (int r4 = 0; r4 < 16; r4 += 4) {
        h8 a[4], b[4];
#pragma unroll
        for (int r = 0; r < 4; ++r) { const half_t* vr = V + (size_t)(tok0 + 16 * w + r4 + r) * DM; a[r] = *(const h8*)(vr + lane * 8); b[r] = *(const h8*)(vr + 512 + lane * 8); }
        asm volatile("" ::: "memory");
#pragma unroll
        for (int r = 0; r < 4; ++r) {
            const int t = 16 * w + r4 + r;
            float s = 0.f, s2 = 0.f;
#pragma unroll
            for (int i = 0; i < 8; ++i) { const float x0 = (float)a[r][i], x1 = (float)b[r][i]; s += x0 + x1; s2 += x0 * x0 + x1 * x1; }
            s = wave_sum(s); s2 = wave_sum(s2);
            const float mu = s * (1.f / DM), var = fmaxf(s2 * (1.f / DM) - mu * mu, 0.f);
            if (lane == 0) { mean[t] = mu; rstd[t] = 1.f / sqrtf(var + 1e-5f); }
        }
    }
    __syncthreads();
    for (int g = 0; g < 8; ++g) {
        f32x4 wvv[8];
#pragma unroll
        for (int i = 0; i < 8; ++i) { const int idx = tid + 512 * i, t = idx >> 5, s4 = idx & 31; wvv[i] = *(const f32x4*)(GP(P->gm_ws) + ((size_t)(g * 128 + t)) * 128 + 4 * s4); }
        h8 vvv[4];
#pragma unroll
        for (int i = 0; i < 4; ++i) { const int idx = i * 8 + w, cc8 = idx & 15, s = (idx >> 4) * 64 + lane; vvv[i] = *(const h8*)(V + (size_t)(tok0 + s) * DM + g * 128 + 8 * cc8); }
        asm volatile("" ::: "memory");
#pragma unroll
        for (int i = 0; i < 8; ++i) {
            const int idx = tid + 512 * i, t = idx >> 5, s4 = idx & 31;
            f32x4 wv = wvv[i];
            if ((t >> 6) < ((4 * s4) >> 6)) wv = (f32x4){0.f, 0.f, 0.f, 0.f};
            h4 hv; hv[0] = (half_t)wv[0]; hv[1] = (half_t)wv[1]; hv[2] = (half_t)wv[2]; hv[3] = (half_t)wv[3];
            *(h4*)(Ws + t * 136 + 4 * s4) = hv;
        }
#pragma unroll
        for (int i = 0; i < 4; ++i) {
            const int idx = i * 8 + w, cc8 = idx & 15, s = (idx >> 4) * 64 + lane;
            const h8 v = vvv[i];
            const float mu = mean[s], rs = rstd[s];
            const f32x4 ga = *(const f32x4*)(GP(P->gm_g) + g * 128 + 8 * cc8), gb = *(const f32x4*)(GP(P->gm_g) + g * 128 + 8 * cc8 + 4);
            const f32x4 ba = *(const f32x4*)(GP(P->gm_b) + g * 128 + 8 * cc8), bb = *(const f32x4*)(GP(P->gm_b) + g * 128 + 8 * cc8 + 4);
#pragma unroll
            for (int k = 0; k < 8; ++k) {
                const float gg = k < 4 ? ga[k & 3] : gb[k & 3], bt = k < 4 ? ba[k & 3] : bb[k & 3];
                vnT[(8 * cc8 + k) * 136 + s] = (half_t)(((float)v[k] - mu) * rs * gg + bt);
            }
        }
        __syncthreads();
        const int nks = w < 4 ? 2 : 4;
        h8 Bf[4];
#pragma unroll
        for (int ks = 0; ks < 4; ++ks) Bf[ks] = *(const h8*)(Ws + (16 * w + l15) * 136 + 32 * ks + 8 * quad);
        const int t = 16 * w + l15;
        const float bias = GP(P->gm_bs)[g * 128 + t];
        h4 uvv[8];
#pragma unroll
        for (int ct = 0; ct < 8; ++ct) uvv[ct] = *(const h4*)(U + (size_t)(tok0 + t) * YAB + g * 128 + 16 * ct + 4 * quad);
#pragma unroll
        for (int ct = 0; ct < 8; ++ct) {
            f32x4 acc = (f32x4){0.f, 0.f, 0.f, 0.f};
#pragma unroll
            for (int ks = 0; ks < 4; ++ks) if (ks < nks) {
                const h8 Af = *(const h8*)(vnT + (16 * ct + l15) * 136 + 32 * ks + 8 * quad);
                acc = __builtin_amdgcn_mfma_f32_16x16x32_f16(Af, Bf[ks], acc, 0, 0, 0);
            }
            half_t* up = U + (size_t)(tok0 + t) * YAB + g * 128 + 16 * ct + 4 * quad;
            const h4 uv = uvv[ct]; h4 y;
#pragma unroll
            for (int j = 0; j < 4; ++j) y[j] = (half_t)((float)uv[j] * (acc[j] + bias));
            if (!dry) *(h4*)up = y;
        }
        __syncthreads();
    }
}

constexpr int HB_QD = 0, HB_QDB = 4352, HB_KDEC = 8704, HB_KET = 13056, HB_VT = 18176, HB_DEC = 23296, HB_OB = 23808, HB_SIZE = 32256;
constexpr int SEGL = 512, NSEG = 16, NCH = 32, NITEM = 32 * NSEG;

template <bool EMIT>
__device__ __forceinline__ void hgrn_item(KP P, unsigned char* lds, int item, bool dry = false) {
    unsigned char* ws = sopq(GP(P->ws));
    const int tid = otid(), lane = tid & 63, w = tid >> 6, l15 = lane & 15, quad = lane >> 4;
    const int bh = item / NSEG, seg = item % NSEG, b = bh >> 3, h = bh & 7;
    const int tokbase = b * 8192 + seg * SEGL, colbase = h * 128;
    const half_t* Q = (const half_t*)(ws + OFF_S4); const half_t* F = (const half_t*)(ws + OFF_S5); const half_t* I = (const half_t*)(ws + OFF_S6);
    half_t* Gp = (half_t*)(ws + OFF_S2) + DM;
    const float* decay = (const float*)(ws + OFF_DECAY);
    float* Sbuf = (float*)(ws + OFF_S1) + (size_t)item * 16384;
    const int half = tid >> 8, pp = tid & 255, st = pp & 15, sc8 = pp >> 4;
    f32x4 S[8];
#pragma unroll
    for (int dt = 0; dt < 8; ++dt) {
        if (EMIT) {
#pragma unroll
            for (int r = 0; r < 4; ++r) S[dt][r] = Sbuf[((w * 8 + dt) * 4 + r) * 64 + lane];
        } else S[dt] = (f32x4){0.f, 0.f, 0.f, 0.f};
    }
    float dprod = 1.f;
    h8 r0, r1; f32x4 rd0, rd1; h2 gcur[2], gprev[2];
    { const float one = __int_as_float(vopq(0x3f800000)); rd0 = rd1 = (f32x4){one, one, one, one}; const half_t hz = (half_t)__int_as_float(vopq(0)); r1 = r0 = (h8)hz; }
    { const half_t hz = (half_t)__int_as_float(vopq(0)); gcur[0] = gcur[1] = gprev[0] = gprev[1] = (h2)hz; }
    const float og0 = GP(P->hg_g)[colbase + 2 * lane], og1 = GP(P->hg_g)[colbase + 2 * lane + 1];
    {
        const size_t o = (size_t)(tokbase + st) * DM + colbase + 8 * sc8;
        if (half == 0) { r0 = *(const h8*)(Q + o); r1 = *(const h8*)(F + o); const float* dp = decay + (size_t)(tokbase >> 4) * DM + colbase + 8 * sc8; rd0 = *(const f32x4*)dp; rd1 = *(const f32x4*)(dp + 4); }
        else r0 = *(const h8*)(I + o);
    }
#pragma unroll 1
    for (int c = 0; c < NCH; ++c) {
        unsigned char* base = lds + (c & 1) * HB_SIZE;
        if (half == 0) {
            *(h8*)(base + HB_QD + (st * 136 + 8 * sc8) * 2) = r0;
            s8v qb, kb;
#pragma unroll
            for (int i = 0; i < 8; ++i) {
                qb[i] = (short)f2bf((float)r0[i]);
                const float dv = i < 4 ? rd0[i & 3] : rd1[i & 3];
                kb[i] = (short)f2bf((float)r1[i] * __builtin_amdgcn_rcpf(dv));
                *(half_t*)(base + HB_KET + ((8 * sc8 + i) * 20 + st) * 2) = r1[i];
            }
            *(s8v*)(base + HB_QDB + (st * 136 + 8 * sc8) * 2) = qb;
            *(s8v*)(base + HB_KDEC + (st * 136 + 8 * sc8) * 2) = kb;
            if (st == 0) { float* dq = (float*)(base + HB_DEC) + 8 * sc8; *(f32x4*)dq = rd0; *(f32x4*)(dq + 4) = rd1; }
        } else {
#pragma unroll
            for (int i = 0; i < 8; ++i) *(half_t*)(base + HB_VT + ((8 * sc8 + i) * 20 + st) * 2) = r0[i];
        }
        if (EMIT) {
            gprev[0] = gcur[0]; gprev[1] = gcur[1];
#pragma unroll
            for (int tt = 0; tt < 2; ++tt) gcur[tt] = *(const h2*)(Gp + (size_t)(tokbase + c * 16 + 2 * w + tt) * YAB + colbase + 2 * lane);
        }
        if (c + 1 < NCH) {
            const size_t o = (size_t)(tokbase + (c + 1) * 16 + st) * DM + colbase + 8 * sc8;
            if (half == 0) { r0 = *(const h8*)(Q + o); r1 = *(const h8*)(F + o); const float* dp = decay + (size_t)((tokbase >> 4) + c + 1) * DM + colbase + 8 * sc8; rd0 = *(const f32x4*)dp; rd1 = *(const f32x4*)(dp + 4); }
            else r0 = *(const h8*)(I + o);
        }
        __syncthreads();
        if (!EMIT) { if (tid < 128) dprod *= ((const float*)(base + HB_DEC))[tid]; }
        if (EMIT && c >= 1) {
            const float* ob = (const float*)(lds + ((c - 1) & 1) * HB_SIZE + HB_OB);
#pragma unroll
            for (int tt = 0; tt < 2; ++tt) {
                const int t = 2 * w + tt;
                const f32x2 v = *(const f32x2*)(ob + t * 132 + 2 * lane);
                const float ss = wave_sum(v[0] * v[0] + v[1] * v[1]);
                const float rr = 1.f / sqrtf(ss * (1.f / 128.f) + 1e-6f);
                const float g0 = (float)gprev[tt][0], g1 = (float)gprev[tt][1];
                h2 y; y[0] = (half_t)(v[0] * rr * og0 * g0); y[1] = (half_t)(v[1] * rr * og1 * g1);
                if (!dry) *(h2*)(Gp + (size_t)(tokbase + (c - 1) * 16 + t) * YAB + colbase + 2 * lane) = y;
            }
        }
        const h4 vB = *(const h4*)(base + HB_VT + ((16 * w + l15) * 20 + 4 * quad) * 2);
        if (EMIT) {
            f32x4 sc = (f32x4){0.f, 0.f, 0.f, 0.f};
#pragma unroll
            for (int ks = 0; ks < 4; ++ks) {
                const s8v ka = *(const s8v*)(base + HB_KDEC + (l15 * 136 + 32 * ks + 8 * quad) * 2);
                const s8v qb = *(const s8v*)(base + HB_QDB + (l15 * 136 + 32 * ks + 8 * quad) * 2);
                sc = __builtin_amdgcn_mfma_f32_16x16x32_bf16(__builtin_bit_cast(__attribute__((ext_vector_type(8))) __bf16, ka), __builtin_bit_cast(__attribute__((ext_vector_type(8))) __bf16, qb), sc, 0, 0, 0);
            }
            h4 scA;
#pragma unroll
            for (int r = 0; r < 4; ++r) scA[r] = (half_t)((4 * quad + r) <= l15 ? sc[r] : 0.f);
            f32x4 o = __builtin_amdgcn_mfma_f32_16x16x16f16(scA, vB, (f32x4){0.f, 0.f, 0.f, 0.f}, 0, 0, 0); MFMA16_KEEP(scA, vB);
#pragma unroll
            for (int ks = 0; ks < 4; ++ks) {
                const h4 qa = *(const h4*)(base + HB_QD + (l15 * 136 + 32 * ks + 4 * quad) * 2);
                const h4 qc = *(const h4*)(base + HB_QD + (l15 * 136 + 32 * ks + 16 + 4 * quad) * 2);
                h8 qA, sB;
#pragma unroll
                for (int j = 0; j < 4; ++j) { qA[j] = qa[j]; qA[4 + j] = qc[j]; sB[j] = (half_t)S[2 * ks][j]; sB[4 + j] = (half_t)S[2 * ks + 1][j]; }
                o = __builtin_amdgcn_mfma_f32_16x16x32_f16(qA, sB, o, 0, 0, 0);
            }
            float* ob = (float*)(base + HB_OB);
#pragma unroll
            for (int r = 0; r < 4; ++r) ob[(4 * quad + r) * 132 + 16 * w + l15] = o[r];
        }
#pragma unroll
        for (int dt = 0; dt < 8; ++dt) {
            const f32x4 dv = *(const f32x4*)(base + HB_DEC + (16 * dt + 4 * quad) * 4);
            const h4 kA = *(const h4*)(base + HB_KET + ((16 * dt + l15) * 20 + 4 * quad) * 2);
            S[dt] = __builtin_amdgcn_mfma_f32_16x16x16f16(kA, vB, S[dt] * dv, 0, 0, 0); MFMA16_KEEP(kA, vB);
        }
    }
    if (EMIT) {
        __syncthreads();
        const float* ob = (const float*)(lds + ((NCH - 1) & 1) * HB_SIZE + HB_OB);
#pragma unroll
        for (int tt = 0; tt < 2; ++tt) {
            const int t = 2 * w + tt;
            const f32x2 v = *(const f32x2*)(ob + t * 132 + 2 * lane);
            const float ss = wave_sum(v[0] * v[0] + v[1] * v[1]);
            const float rr = 1.f / sqrtf(ss * (1.f / 128.f) + 1e-6f);
            const float g0 = (float)gcur[tt][0], g1 = (float)gcur[tt][1];
            h2 y; y[0] = (half_t)(v[0] * rr * og0 * g0); y[1] = (half_t)(v[1] * rr * og1 * g1);
            if (!dry) *(h2*)(Gp + (size_t)(tokbase + (NCH - 1) * 16 + t) * YAB + colbase + 2 * lane) = y;
        }
    } else {
#pragma unroll
        for (int dt = 0; dt < 8; ++dt)
#pragma unroll
            for (int r = 0; r < 4; ++r) if (!dry) Sbuf[((w * 8 + dt) * 4 + r) * 64 + lane] = S[dt][r];
        if (tid < 128 && !dry) ((float*)(ws + OFF_DSEG))[(size_t)item * 128 + tid] = dprod;
    }
    __syncthreads();
}


__device__ __forceinline__ void hgrn_pairA(KP P, unsigned char* lds, int item0, int item1) {
    unsigned char* ws = sopq(GP(P->ws));
    const int tid = otid(), lane = tid & 63, w = tid >> 6, l15 = lane & 15, quad = lane >> 4;
    const half_t* F = (const half_t*)(ws + OFF_S5); const half_t* I = (const half_t*)(ws + OFF_S6);
    const float* decay = (const float*)(ws + OFF_DECAY);
    const int half = tid >> 8, pp = tid & 255, st = pp & 15, sc8 = pp >> 4;
    int tokbase[2], colbase[2];
#pragma unroll
    for (int j = 0; j < 2; ++j) { const int item = j ? item1 : item0, bh = item / NSEG, seg = item % NSEG; tokbase[j] = (bh >> 3) * 8192 + seg * SEGL; colbase[j] = (bh & 7) * 128; }
    f32x4 S[2][8];
#pragma unroll
    for (int j = 0; j < 2; ++j)
#pragma unroll
        for (int dt = 0; dt < 8; ++dt) S[j][dt] = (f32x4){0.f, 0.f, 0.f, 0.f};
    float dprod[2] = {1.f, 1.f};
    h8 r[2]; f32x4 rd0[2], rd1[2];
    { const float one = __int_as_float(vopq(0x3f800000)); const half_t hz = (half_t)__int_as_float(vopq(0));
#pragma unroll
      for (int j = 0; j < 2; ++j) { rd0[j] = rd1[j] = (f32x4){one, one, one, one}; r[j] = (h8)hz; } }
#pragma unroll
    for (int j = 0; j < 2; ++j) {
        const size_t o = (size_t)(tokbase[j] + st) * DM + colbase[j] + 8 * sc8;
        if (half == 0) { r[j] = *(const h8*)(F + o); const float* dp = decay + (size_t)(tokbase[j] >> 4) * DM + colbase[j] + 8 * sc8; rd0[j] = *(const f32x4*)dp; rd1[j] = *(const f32x4*)(dp + 4); }
        else r[j] = *(const h8*)(I + o);
    }
#pragma unroll 1
    for (int c = 0; c < NCH; ++c) {
#pragma unroll
        for (int j = 0; j < 2; ++j) {
            unsigned char* base = lds + (2 * j + (c & 1)) * HB_SIZE;
            if (half == 0) {
#pragma unroll
                for (int i = 0; i < 8; ++i) *(half_t*)(base + HB_KET + ((8 * sc8 + i) * 20 + st) * 2) = r[j][i];
                if (st == 0) { float* dq = (float*)(base + HB_DEC) + 8 * sc8; *(f32x4*)dq = rd0[j]; *(f32x4*)(dq + 4) = rd1[j]; }
            } else {
#pragma unroll
                for (int i = 0; i < 8; ++i) *(half_t*)(base + HB_VT + ((8 * sc8 + i) * 20 + st) * 2) = r[j][i];
            }
        }
        if (c + 1 < NCH) {
#pragma unroll
            for (int j = 0; j < 2; ++j) {
                const size_t o = (size_t)(tokbase[j] + (c + 1) * 16 + st) * DM + colbase[j] + 8 * sc8;
                if (half == 0) { r[j] = *(const h8*)(F + o); const float* dp = decay + (size_t)((tokbase[j] >> 4) + c + 1) * DM + colbase[j] + 8 * sc8; rd0[j] = *(const f32x4*)dp; rd1[j] = *(const f32x4*)(dp + 4); }
                else r[j] = *(const h8*)(I + o);
            }
        }
        __syncthreads();
#pragma unroll
        for (int j = 0; j < 2; ++j) {
            unsigned char* base = lds + (2 * j + (c & 1)) * HB_SIZE;
            if (tid < 128) dprod[j] *= ((const float*)(base + HB_DEC))[tid];
            const h4 vB = *(const h4*)(base + HB_VT + ((16 * w + l15) * 20 + 4 * quad) * 2);
#pragma unroll
            for (int dt = 0; dt < 8; ++dt) {
                const f32x4 dv = *(const f32x4*)(base + HB_DEC + (16 * dt + 4 * quad) * 4);
                const h4 kA = *(const h4*)(base + HB_KET + ((16 * dt + l15) * 20 + 4 * quad) * 2);
                S[j][dt] = __builtin_amdgcn_mfma_f32_16x16x16f16(kA, vB, S[j][dt] * dv, 0, 0, 0); MFMA16_KEEP(kA, vB);
            }
        }
    }
#pragma unroll
    for (int j = 0; j < 2; ++j) {
        const int item = j ? item1 : item0;
        float* Sbuf = (float*)(ws + OFF_S1) + (size_t)item * 16384;
#pragma unroll
        for (int dt = 0; dt < 8; ++dt)
#pragma unroll
            for (int rr = 0; rr < 4; ++rr) Sbuf[((w * 8 + dt) * 4 + rr) * 64 + lane] = S[j][dt][rr];
        if (tid < 128) ((float*)(ws + OFF_DSEG))[(size_t)item * 128 + tid] = dprod[j];
    }
    __syncthreads();
}

__device__ __forceinline__ void phase_scan(KP P) {
    unsigned char* ws = sopq(GP(P->ws));
    float* Sb = (float*)(ws + OFF_S1); const float* Ds = (const float*)(ws + OFF_DSEG);
    const int N = gridDim.x * 512;
    for (int e4 = blockIdx.x * 512 + otid(); e4 < 32 * 4096; e4 += N) {
        const int bh = e4 >> 12, idx = (e4 & 4095) * 4;
        const int ln = idx & 63, r = (idx >> 6) & 3, dt = (idx >> 8) & 7, d = 16 * dt + 4 * (ln >> 4) + r;
        f32x4 run = (f32x4){0.f, 0.f, 0.f, 0.f};
#pragma unroll 1
        for (int s0 = 0; s0 < NSEG; s0 += 8) {
            f32x4 loc[8]; float dd[8];
#pragma unroll
            for (int k = 0; k < 8; ++k) {
                const int seg = s0 + k;
                if (seg < NSEG - 1) { loc[k] = *(const f32x4*)(Sb + ((size_t)(bh * NSEG + seg)) * 16384 + idx); dd[k] = Ds[(size_t)(bh * NSEG + seg) * 128 + d]; }
                else { loc[k] = (f32x4){0.f, 0.f, 0.f, 0.f}; dd[k] = 0.f; }
            }
            asm volatile("" ::: "memory");
#pragma unroll
            for (int k = 0; k < 8; ++k) {
                const int seg = s0 + k;
                *(f32x4*)(Sb + ((size_t)(bh * NSEG + seg)) * 16384 + idx) = run;
                run = run * dd[k] + loc[k];
            }
            asm volatile("" ::: "memory");
        }
    }
}

__device__ __forceinline__ void phase_ln(KP P, const half_t* src, const float* g, const float* b, half_t* o16, float* o32, unsigned short* ob16 = nullptr) {
    constexpr int NR = 4;
    const int tidl = otid(); const int lane = tidl & 63, gw = blockIdx.x * 8 + (tidl >> 6), stride = gridDim.x * 8;
    for (int row0 = gw; row0 < T; row0 += NR * stride) {
        h8 a[NR], c[NR];
#pragma unroll
        for (int r = 0; r < NR; ++r) { const int row = row0 + r * stride < T ? row0 + r * stride : row0; const half_t* xr = src + (size_t)row * DM; a[r] = *(const h8*)(xr + 8 * lane); c[r] = *(const h8*)(xr + 512 + 8 * lane); }
        asm volatile("" ::: "memory");
#pragma unroll
        for (int r = 0; r < NR; ++r) {
            const int row = row0 + r * stride;
            if (row < T) {
                float v[16]; float s1 = 0.f;
#pragma unroll
                for (int i = 0; i < 8; ++i) { v[i] = (float)a[r][i]; v[8 + i] = (float)c[r][i]; s1 += v[i] + v[8 + i]; }
                const float mean = wave_sum(s1) * (1.f / DM); float s2 = 0.f;
#pragma unroll
                for (int i = 0; i < 16; ++i) { v[i] -= mean; s2 += v[i] * v[i]; }
                const float rstd = 1.f / sqrtf(wave_sum(s2) * (1.f / DM) + 1e-5f);
#pragma unroll
                for (int hf = 0; hf < 2; ++hf) {
                    const int col = 512 * hf + 8 * lane;
                    const f32x4 g0 = *(const f32x4*)(g + col), g1 = *(const f32x4*)(g + col + 4), b0 = *(const f32x4*)(b + col), b1 = *(const f32x4*)(b + col + 4);
                    f32x4 y0, y1;
#pragma unroll
                    for (int j = 0; j < 4; ++j) { y0[j] = v[8 * hf + j] * rstd * g0[j] + b0[j]; y1[j] = v[8 * hf + 4 + j] * rstd * g1[j] + b1[j]; }
                    if (o16) *(h8*)(o16 + (size_t)row * DM + col) = pack8(y0, y1);
                    if (ob16) *(s8v*)(ob16 + (size_t)row * DM + col) = pack8b(y0, y1);
                    if (o32) { *(f32x4*)(o32 + (size_t)row * DM + col) = y0; *(f32x4*)(o32 + (size_t)row * DM + col + 4) = y1; }
                }
            }
        }
    }
}

#define XB_TMO      128
#define XB_XCNT(j)  (256  + 64 * (j))
#define XB_XSUB(j)  (1280 + 64 * (j))
#define XB_XGEN(j)  (2304 + 64 * (j))
#define XB_TOP      3328
#define XB_TOPGEN   3392
#define XCD_BAR_WORDS 3456
#define XB_SPIN_CAP (1u << 18)
__device__ __forceinline__ unsigned xb_ld(unsigned* p)              { return __hip_atomic_load(p, __ATOMIC_RELAXED, __HIP_MEMORY_SCOPE_AGENT); }
__device__ __forceinline__ unsigned xb_add(unsigned* p, unsigned v) { return __hip_atomic_fetch_add(p, v, __ATOMIC_RELAXED, __HIP_MEMORY_SCOPE_AGENT); }
__device__ __forceinline__ unsigned xb_xcc_id() { return (unsigned)__builtin_amdgcn_s_getreg((3 << 11) | 20) & 0xFu; }
#define XB_SPIN(cond, bar) do { unsigned _sp = 0; while (cond) { __builtin_amdgcn_s_sleep(1); \
    if ((++_sp & 255u) == 0u) { if (xb_ld(&(bar)[XB_TMO])) break; if (_sp > XB_SPIN_CAP) { atomicAdd(&(bar)[XB_TMO], 1u); break; } } } } while (0)
struct XcdBarrier { unsigned* bar; unsigned x; volatile LAS unsigned* st; };
__device__ __forceinline__ XcdBarrier xcd_barrier_post(unsigned* bar, volatile LAS unsigned* st) {
    XcdBarrier b; b.bar = bar; b.x = xb_xcc_id(); b.st = st;
    if (otid() == 0) (void)xb_add(&bar[XB_XCNT(b.x)], 1u);
    return b;
}
__device__ __forceinline__ void xcd_barrier_complete(unsigned* bar, unsigned x, unsigned& nloc, unsigned& nx) {
    const unsigned G = gridDim.x * gridDim.y * gridDim.z;
    unsigned sum, cnt, mine, sp = 0u;
    for (;;) {
        sum = 0u; cnt = 0u; mine = 0u;
#pragma unroll
        for (unsigned j = 0; j < 16; ++j) { const unsigned c = xb_ld(&bar[XB_XCNT(j)]); sum += c; cnt += (c > 0u) ? 1u : 0u; mine = (j == x) ? c : mine; }
        if (sum == G) break;
        __builtin_amdgcn_s_sleep(1);
        if ((++sp & 255u) == 0u) { if (xb_ld(&bar[XB_TMO])) break; if (sp > XB_SPIN_CAP) { atomicAdd(&bar[XB_TMO], 1u); break; } }
    }
    nloc = mine > 0u ? mine : 1u; nx = cnt > 0u ? cnt : 1u;
}
__device__ __forceinline__ void xcd_barrier(const XcdBarrier& b) {
    asm volatile("s_waitcnt vmcnt(0)" ::: "memory");
    __syncthreads();
    if (otid() == 0) {
        unsigned* bar = b.bar;
        __builtin_amdgcn_s_waitcnt(0);
        unsigned nloc = b.st[0], nx = b.st[1];
        if (nloc == 0u) { xcd_barrier_complete(bar, b.x, nloc, nx); b.st[0] = nloc; b.st[1] = nx; }
        const unsigned old = xb_add(&bar[XB_XSUB(b.x)], 1u);
        const unsigned gen = old / nloc;
        if (old + 1u == (gen + 1u) * nloc) {
            __builtin_amdgcn_fence(__ATOMIC_RELEASE, "agent");
            asm volatile("s_waitcnt vmcnt(0)" ::: "memory");
            const unsigned og = xb_add(&bar[XB_TOP], 1u);
            const unsigned tg = og / nx;
            if (og + 1u == (tg + 1u) * nx) xb_add(&bar[XB_TOPGEN], 1u);
            else XB_SPIN(xb_ld(&bar[XB_TOPGEN]) == tg, bar);
            __builtin_amdgcn_fence(__ATOMIC_ACQUIRE, "agent");
            xb_add(&bar[XB_XGEN(b.x)], 1u);
            asm volatile("s_waitcnt vmcnt(0)" ::: "memory");
        } else {
            XB_SPIN(xb_ld(&bar[XB_XGEN(b.x)]) == gen, bar);
            __builtin_amdgcn_fence(__ATOMIC_ACQUIRE, "agent");
            asm volatile("s_waitcnt vmcnt(0)" ::: "memory");
        }
    }
    __syncthreads();
}

__global__ void __launch_bounds__(512, 2) mega(Params Pk) {
    KP P = kp_get();
    extern __shared__ __attribute__((aligned(16))) unsigned char shm[];
    cg::grid_group grid = cg::this_grid();
    unsigned char* ws = sopq(GP(P->ws));
    const int G = gridDim.x;
    volatile LAS unsigned* xst = (volatile LAS unsigned*)((LAS unsigned char*)shm + pg8::STAGE_BYTES);
#if USE_XCD
    if (otid() == 0) { xst[0] = 0u; xst[1] = 0u; }
    __syncthreads();
    (void)xcd_barrier_post((unsigned*)(ws + OFF_BAR), xst);
    if (P->ph1 < 0) grid.sync();
#endif
#pragma unroll 1
    for (int pi = P->ph0; pi < P->ph1; ++pi) {
        const int ph = PROG[pi];
        P = kp_get();
        unsigned char* ws = sopq(GP(P->ws));
        int gk = -1, hk = -1, bfk = 0; pg8::Gemm g; g.M = T; g.A = nullptr; g.Bt = nullptr; g.N = DM; g.K = DM;
        switch (ph) {
            case 1: gk = EK_PROJ; bfk = BF_P1; g.A = (const half_t*)(ws + OFF_S1); g.Bt = (const half_t*)(ws + OFF_WIN); g.N = DIN; g.K = DM; break;
            case 5: gk = EK_MRG; hk = 16; g.A = (const half_t*)(ws + OFF_S2); g.Bt = (const half_t*)(ws + OFF_WA); g.K = YAB; break;
            case 7: gk = EK_WO; g.A = (const half_t*)(ws + OFF_S5); g.Bt = (const half_t*)(ws + OFF_WO); break;
            case 9: gk = EK_FFN; bfk = BF_P9; g.A = (const half_t*)(ws + (BF_P9 ? OFF_S4 : OFF_S1)); g.Bt = (const half_t*)(ws + OFF_WGU); g.N = 6656; break;
            case 11: gk = EK_DOWN; hk = 4; g.A = (const half_t*)(ws + OFF_S5); g.Bt = (const half_t*)(ws + OFF_WD); g.K = HPW; break;
            default: break;
        }
        if (gk >= 0) {
            if (gk == EK_PROJ) {
                const int t0 = otid(); const float* bsrc = (const float*)(ws + OFF_BINP); const float* lsrc = (const float*)(ws + OFF_LB);
                LAS half_t* bl = (LAS half_t*)((LAS unsigned char*)shm + LDS_BIAS); LAS float* ll = (LAS float*)((LAS unsigned char*)shm + LDS_LB);
                for (int i = t0; i < DIN; i += 512) bl[i] = (half_t)bsrc[i];
                for (int i = t0; i < DM; i += 512) ll[i] = lsrc[i];
                __syncthreads();
            }
            pg8::StaticOrder S; S.init(g.M, g.N, G, blockIdx.x);
            Epi E; E.kind = gk; E.hook_t = hk; E.P = P; E.lds = (LAS unsigned char*)shm;
            if (bfk) pg8::gemm_phase<Epi, true>((LAS unsigned char*)shm, g, S, E); else pg8::gemm_phase<Epi>((LAS unsigned char*)shm, g, S, E);
        } else if (ph == 0) {
            phase_prep(P, shm);
        } else if (ph == 2) {
            for (int it = blockIdx.x; it < 256; it += G) gmlp_item(P, shm, it);
            for (int it = blockIdx.x; it < NITEM; it += 2 * G) {
                const int it1 = it + G; const bool v0 = (it % NSEG) != NSEG - 1, v1 = it1 < NITEM && (it1 % NSEG) != NSEG - 1;
                if (v0 && v1) hgrn_pairA(P, shm, it, it1);
                else { if (v0) hgrn_item<false>(P, shm, it); if (v1) hgrn_item<false>(P, shm, it1); }
            }
        } else if (ph == 3) {
            phase_scan(P);
        } else if (ph == 4) {
            for (int it = blockIdx.x; it < NITEM; it += G) hgrn_item<true>(P, shm, it);
        } else if (ph == 8) {
            phase_ln(P, (const half_t*)(ws + OFF_S3), GP(P->ln1_g), GP(P->ln1_b), (half_t*)(ws + OFF_S1), nullptr, BF_P9 ? (unsigned short*)(ws + OFF_S4) : nullptr);
            half_t* p16 = (half_t*)(ws + OFF_S5);
            {
                const int i0 = blockIdx.x * 512 + otid(), str = G * 512;
                for (int it = 0; it < 8; it += 4) {
                    f32x4 pa[4], pb[4];
#pragma unroll
                    for (int k = 0; k < 4; ++k) { const int i = i0 + (it + k) * str; const int ic = i < T * PLE / 8 ? i : i0; pa[k] = *(const f32x4*)(GP(P->p) + (size_t)ic * 8); pb[k] = *(const f32x4*)(GP(P->p) + (size_t)ic * 8 + 4); }
                    asm volatile("" ::: "memory");
#pragma unroll
                    for (int k = 0; k < 4; ++k) { const int i = i0 + (it + k) * str; if (i < T * PLE / 8) *(h8*)(p16 + (size_t)(i >> 5) * HPW + (i & 31) * 8) = pack8(pa[k], pb[k]); }
                }
                for (int i = i0 + 8 * str; i < T * PLE / 8; i += str) {
                    const f32x4 a = *(const f32x4*)(GP(P->p) + (size_t)i * 8), b = *(const f32x4*)(GP(P->p) + (size_t)i * 8 + 4);
                    *(h8*)(p16 + (size_t)(i >> 5) * HPW + (i & 31) * 8) = pack8(a, b);
                }
            }
        } else if (ph == 12) {
            phase_ln(P, (const half_t*)(ws + OFF_S3), GP(P->ln2_g), GP(P->ln2_b), nullptr, GP(P->out));
        }
        if (pi + 1 < P->ph1) {
#if USE_XCD
            { XcdBarrier xb; xb.bar = (unsigned*)(ws + OFF_BAR); xb.x = xb_xcc_id(); xb.st = xst; xcd_barrier(xb); }
#else
            grid.sync();
#endif
        }
    }
}

extern "C" void kernel_launch(void* const* d_in, const int* in_sizes, int n_in, void* d_out, int out_size, void* d_ws, size_t ws_size, hipStream_t stream) {
    static int grid = 0;
    constexpr int LDS_BYTES = LDS_TOTAL;
    if (grid == 0) {
        if (n_in != 25 || ws_size < WS_NEED || out_size != T * DM) { fprintf(stderr, "kernel_launch: unexpected shapes n_in %d ws %zu out %d\n", n_in, ws_size, out_size); grid = -1; return; }
        int dev = 0, cus = 0, per_cu = 0;
        hipGetDevice(&dev);
        hipDeviceGetAttribute(&cus, hipDeviceAttributeMultiprocessorCount, dev);
        hipFuncSetAttribute((const void*)mega, hipFuncAttributeMaxDynamicSharedMemorySize, LDS_BYTES);
        hipOccupancyMaxActiveBlocksPerMultiprocessor(&per_cu, (const void*)mega, 512, LDS_BYTES);
        if (per_cu < 1) { fprintf(stderr, "kernel_launch: occupancy query says %d blocks per CU\n", per_cu); per_cu = 1; }
        (void)hipGetLastError();
        grid = cus;
    }
    if (grid < 0) return;
    Params P{};
#if USE_XCD && !MK_MULTI
    (void)hipMemsetAsync((unsigned char*)d_ws + OFF_BAR, 0, XCD_BAR_WORDS * 4, stream);
#endif
    const float** f = (const float**)&P;
    for (int i = 0; i < 25; ++i) f[i] = (const float*)d_in[i];
    P.out = (float*)d_out; P.ws = (unsigned char*)d_ws;
#if MK_MULTI
    for (int ph = 0; ph < NPH; ++ph) {
        P.ph0 = ph; P.ph1 = ph + 1;
        void* args[] = {&P};
        hipError_t e = hipLaunchCooperativeKernel((const void*)mega, dim3(grid), dim3(512), args, LDS_BYTES, stream);
        if (e != hipSuccess) fprintf(stderr, "launch failed: %s\n", hipGetErrorString(e));
    }
#else
    P.ph0 = 0; P.ph1 = NPH;
    void* args[] = {&P};
    hipError_t e = hipLaunchCooperativeKernel((const void*)mega, dim3(grid), dim3(512), args, LDS_BYTES, stream);
    if (e != hipSuccess) fprintf(stderr, "cooperative launch failed: %s (grid %d)\n", hipGetErrorString(e), grid);
#endif
}
```

```cpp
#include <hip/hip_runtime.h>
#include <hip/hip_cooperative_groups.h>
#include <cstdio>
namespace cg = cooperative_groups;

#ifndef BF_P1
#define BF_P1 1
#endif
#ifndef BF_P9
#define BF_P9 1
#endif
#ifndef USE_XCD
#define USE_XCD 1
#endif
#ifndef MK_MULTI
#define MK_MULTI 0
#endif

#define LAS __attribute__((address_space(3)))
typedef _Float16 half_t;
typedef _Float16 h8 __attribute__((ext_vector_type(8)));
typedef _Float16 h4 __attribute__((ext_vector_type(4)));
typedef _Float16 h2 __attribute__((ext_vector_type(2)));
typedef short s8v __attribute__((ext_vector_type(8)));
typedef float f32x4 __attribute__((ext_vector_type(4)));
typedef __bf16 bf8v __attribute__((ext_vector_type(8)));
typedef float f32x2 __attribute__((ext_vector_type(2)));

constexpr int T = 32768, DM = 1024, DIN = 8192, DFF = 2816, PLE = 256, YAB = 2048, HPW = 3072;
constexpr float ALPHA = 1.189207115002721f;
constexpr size_t MiB = (size_t)1 << 20;
constexpr size_t OFF_WIN = 0, OFF_WA = 16 * MiB, OFF_WB = 18 * MiB, OFF_WO = 20 * MiB, OFF_WGU = 22 * MiB, OFF_WD = 35 * MiB, OFF_WPLE = 40 * MiB + 512 * 1024;
constexpr size_t OFF_BINP = 41 * MiB, OFF_LB = 41 * MiB + 32768, OFF_ST0 = 41 * MiB + 65536, OFF_DSEG = 42 * MiB, OFF_DECAY = 43 * MiB;
constexpr size_t OFF_BAR = 52 * MiB;
constexpr size_t OFF_S1 = 64 * MiB, OFF_S2 = 128 * MiB, OFF_S3 = 192 * MiB, OFF_S4 = 256 * MiB, OFF_S5 = 320 * MiB, OFF_S6 = 384 * MiB, OFF_S7 = 448 * MiB, OFF_P16 = 496 * MiB;
constexpr size_t WS_NEED = 512 * MiB;
#ifndef PROG_LIST
#define PROG_LIST 0, 1, 2, 3, 4, 5, 7, 8, 9, 11, 12
#endif
__device__ const int PROG[] = {PROG_LIST};
constexpr int PROG_HOST[] = {PROG_LIST};
constexpr int NPH = sizeof(PROG_HOST) / sizeof(int);

struct Params {
    const float *x, *p, *ln0_g, *ln0_b, *w_in, *b_in, *gm_g, *gm_b, *gm_ws, *gm_bs, *lbl, *hg_g, *w_a, *w_b, *w_o, *ln1_g, *ln1_b, *wg, *wu, *wd, *wple, *wpg, *bpg, *ln2_g, *ln2_b;
    float* out; unsigned char* ws;
    int ph0, ph1;
};

__device__ __forceinline__ int otid() { int t; asm volatile("v_mov_b32 %0, %1" : "=v"(t) : "v"((int)threadIdx.x)); return t; }
__device__ __forceinline__ int vopq(int x) { int t; asm volatile("v_mov_b32 %0, %1" : "=v"(t) : "v"(x)); return t; }
#define GAS __attribute__((address_space(1)))
template <class Tp> __device__ __forceinline__ Tp* GP(Tp* p) { return (Tp*)(Tp GAS*)p; }
typedef const Params __attribute__((address_space(4)))* KP;
__device__ __forceinline__ KP kp_get() { unsigned long long v; asm volatile("s_mov_b64 %0, %1" : "=s"(v) : "s"((unsigned long long)__builtin_amdgcn_kernarg_segment_ptr())); return (KP)v; }
__device__ __forceinline__ unsigned char* sopq(unsigned char* p) { unsigned long long v; asm volatile("s_mov_b64 %0, %1" : "=s"(v) : "s"((unsigned long long)p)); return (unsigned char*)(unsigned char GAS*)v; }
__device__ __forceinline__ float sigm(float x) { return __builtin_amdgcn_rcpf(1.f + __expf(-x)); }
__device__ __forceinline__ float wave_sum(float v) {
#pragma unroll
    for (int o = 1; o < 64; o <<= 1) v += __shfl_xor(v, o);
    return v;
}
__device__ __forceinline__ unsigned short f2bf(float f) { unsigned u = __float_as_uint(f); u += 0x7FFFu + ((u >> 16) & 1u); return (unsigned short)(u >> 16); }
__device__ __forceinline__ h8 pack8(f32x4 a, f32x4 b) { h8 v; v[0] = (half_t)a[0]; v[1] = (half_t)a[1]; v[2] = (half_t)a[2]; v[3] = (half_t)a[3]; v[4] = (half_t)b[0]; v[5] = (half_t)b[1]; v[6] = (half_t)b[2]; v[7] = (half_t)b[3]; return v; }
__device__ __forceinline__ s8v pack8b(f32x4 a, f32x4 b) { s8v v;
#pragma unroll
    for (int i = 0; i < 4; ++i) { v[i] = (short)f2bf(a[i]); v[4 + i] = (short)f2bf(b[i]); }
    return v; }
#define MFMA16_KEEP(a, b) asm volatile("" :: "v"(a), "v"(b))
__device__ __forceinline__ int map_win(int r) {
    if (r < 2048 || (r >= 4096 && r < 6144)) return r;
    const int rho = r & 255;
    if (r >= 6144) { const int j = (r - 6144) >> 8; return rho < 128 ? 6144 + 128 * j + rho : 7168 + 128 * j + rho - 128; }
    const int h = (r - 2048) >> 8;
    return rho < 128 ? 2048 + 128 * h + rho : 3072 + 128 * h + rho - 128;
}

namespace pg8 {
constexpr int BM = 256, BK = 64, HALF = 128, HTB = HALF * BK * 2, STAGE_BYTES = 8 * HTB, NXCD = 8, WGM = 8;
__host__ __device__ __forceinline__ int lds_byte(int r, int c) { const int st = (r >> 4) * 2 + (c >> 5), rr = r & 15, cc = c & 31, ob = rr * 64 + cc * 2; return st * 1024 + (ob ^ (((ob >> 9) & 1) << 5)); }
__host__ __device__ __forceinline__ void stage_rc(int b, int& R, int& C) { const int st = b / 1024, sb = b % 1024, swz = sb ^ (((sb >> 9) & 1) << 5); R = (st >> 1) * 16 + swz / 64; C = (st & 1) * 32 + (swz % 64) / 2; }
__host__ __device__ __forceinline__ int perm32(int rho) { const int n = rho >> 4, i = rho & 15; return 8 * (i >> 2) + 4 * n + (i & 3); }
struct Unit { int pm, pn; };
struct Gemm { const half_t* A; const half_t* Bt; int M, N, K; };
struct StaticOrder {
    int nM, nN, nwg, G, c;
    __host__ __device__ void init(int M, int N, int G_, int c_) { nM = M / BM; nN = N / BM; nwg = nM * nN; G = G_; c = c_; }
    __host__ __device__ bool next(int i, Unit& u) const {
        const long L = (long)i * G + c; if (L >= nwg) return false;
        int wgid = (int)L; { const int q = nwg / NXCD, r = nwg % NXCD, xcd = wgid % NXCD, off = wgid / NXCD; wgid = (xcd < r ? xcd * (q + 1) : r * (q + 1) + (xcd - r) * q) + off; }
        const int nig = WGM * nN, gid = wgid / nig, fm = gid * WGM, gsz = (nM - fm) < WGM ? (nM - fm) : WGM;
        u.pm = fm + ((wgid % nig) % gsz); u.pn = (wgid % nig) / gsz; return true;
    }
};

template <class Epi, bool BF = false>
__device__ __forceinline__ void gemm_phase(LAS unsigned char* lds, const Gemm g, const StaticOrder& S, const Epi& E) {
    const int tid = otid(), wid = __builtin_amdgcn_readfirstlane(tid >> 6), lane = tid & 63, wr = wid >> 2, wc = wid & 3, fr = lane & 15, fq = lane >> 4;
    const int K = g.K, nt = K / BK;
    unsigned voffA[2], voffB[2];
#pragma unroll
    for (int i = 0; i < 2; ++i) { int R, C; stage_rc(tid * 16 + i * 8192, R, C); const int Rb = (R & ~31) + perm32(R & 31);
        voffA[i] = (unsigned)(R * K + C) * 2u; voffB[i] = (unsigned)(Rb * K + C) * 2u; }
    const size_t kstep = (size_t)(BK * 2);
    const size_t hstep = (size_t)HALF * K * 2;
    const size_t tstep = 2 * hstep;
    const unsigned ldsw = (unsigned)wid * 1024u;
    const int aoff = lds_byte(wr * 64 + fr, fq * 8), boff = lds_byte(wc * 32 + fr, fq * 8);
#define PG8_SA(b, h) (((b) * 2 + (h)) * HTB)
#define PG8_SB(b, h) ((4 + (b) * 2 + (h)) * HTB)
#define PG8_STAGE(bufoff, gbase, voff) do { _Pragma("unroll") for (int _i = 0; _i < 2; ++_i) \
        __builtin_amdgcn_global_load_lds((const unsigned*)((const char*)(gbase) + (voff)[_i]), (LAS unsigned*)(lds + (bufoff) + ldsw + _i * 8192), 16, 0, 0); } while (0)
#define PG8_LDA(dst, b, h) do { _Pragma("unroll") for (int m = 0; m < 4; ++m) _Pragma("unroll") for (int k = 0; k < 2; ++k) dst[m][k] = *(const LAS h8*)(lds + PG8_SA(b, h) + aoff + m * 2048 + k * 1024); } while (0)
#define PG8_LDB(dst, b, h) do { _Pragma("unroll") for (int n = 0; n < 2; ++n) _Pragma("unroll") for (int k = 0; k < 2; ++k) dst[n][k] = *(const LAS h8*)(lds + PG8_SB(b, h) + boff + n * 2048 + k * 1024); } while (0)
#define PG8_MMA(ai, bj, At, Bt) do { __builtin_amdgcn_s_setprio(1); _Pragma("unroll") for (int m = 0; m < 4; ++m) _Pragma("unroll") for (int n = 0; n < 2; ++n) _Pragma("unroll") for (int k = 0; k < 2; ++k) \
        acc[ai][bj][m][n] = BF ? __builtin_amdgcn_mfma_f32_16x16x32_bf16(__builtin_bit_cast(bf8v, Bt[n][k]), __builtin_bit_cast(bf8v, At[m][k]), acc[ai][bj][m][n], 0, 0, 0) \
                               : __builtin_amdgcn_mfma_f32_16x16x32_f16(Bt[n][k], At[m][k], acc[ai][bj][m][n], 0, 0, 0); __builtin_amdgcn_s_setprio(0); } while (0)
#define PG8_WAIT_V(n) asm volatile("s_waitcnt vmcnt(" #n ")" ::: "memory")
#define PG8_WAIT_L(n) asm volatile("s_waitcnt lgkmcnt(" #n ")" ::: "memory")
#define PG8_BAR __builtin_amdgcn_s_barrier()
#define PG8_SCHED __builtin_amdgcn_sched_barrier(0)
    Unit cur, nxt; int ui = 0;
    if (!S.next(0, cur)) return;
    f32x4 acc[2][2][4][2];
#pragma unroll
    for (int a = 0; a < 2; ++a)
#pragma unroll
        for (int b = 0; b < 2; ++b)
#pragma unroll
            for (int m = 0; m < 4; ++m)
#pragma unroll
                for (int n = 0; n < 2; ++n) acc[a][b][m][n] = (f32x4){0.f, 0.f, 0.f, 0.f};
    h8 At[4][2], B0[2][2], B1[2][2];
    const char* cA = (const char*)sopq((unsigned char*)g.A) + (size_t)cur.pm * tstep; const char* cB = (const char*)sopq((unsigned char*)g.Bt) + (size_t)cur.pn * tstep;
    PG8_STAGE(PG8_SB(0, 0), cB, voffB); PG8_STAGE(PG8_SA(0, 0), cA, voffA); PG8_STAGE(PG8_SB(0, 1), cB + hstep, voffB); PG8_STAGE(PG8_SA(0, 1), cA + hstep, voffA);
    if (wr == 1) PG8_BAR;
    PG8_WAIT_V(4); PG8_BAR;
    PG8_STAGE(PG8_SB(1, 0), cB + kstep, voffB); PG8_STAGE(PG8_SA(1, 0), cA + kstep, voffA); PG8_STAGE(PG8_SB(1, 1), cB + hstep + kstep, voffB);
    PG8_WAIT_V(6); PG8_BAR;
    for (;;) {
        const bool has_next = S.next(ui + 1, nxt);
        const char* nA = has_next ? (const char*)sopq((unsigned char*)g.A) + (size_t)nxt.pm * tstep : cA; const char* nB = has_next ? (const char*)sopq((unsigned char*)g.Bt) + (size_t)nxt.pn * tstep : cB;
        for (int t = 0; t < nt; t += 2) {
            if (t == E.hook_t) E.mid(acc, cur, wr, wc, fr, fq);
            const bool last = (t == nt - 2);
            const char* a1 = cA + (size_t)(t + 1) * kstep;
            const char* a2 = last ? nA : cA + (size_t)(t + 2) * kstep; const char* b2 = last ? nB : cB + (size_t)(t + 2) * kstep;
            const char* a3 = a2 + kstep; const char* b3 = b2 + kstep;
            PG8_LDB(B0, 0, 0); PG8_SCHED; PG8_LDA(At, 0, 0); PG8_STAGE(PG8_SA(1, 1), a1 + hstep, voffA);
            PG8_WAIT_L(8); PG8_BAR; PG8_WAIT_L(0); PG8_MMA(0, 0, At, B0); PG8_BAR; PG8_SCHED;
            PG8_LDB(B1, 0, 1); PG8_STAGE(PG8_SB(0, 0), b2, voffB);
            PG8_BAR; PG8_WAIT_L(0); PG8_MMA(0, 1, At, B1); PG8_BAR;
            PG8_LDA(At, 0, 1); PG8_STAGE(PG8_SA(0, 0), a2, voffA);
            PG8_BAR; PG8_WAIT_L(0); PG8_MMA(1, 0, At, B0); PG8_BAR; PG8_SCHED;
            PG8_STAGE(PG8_SB(0, 1), b2 + hstep, voffB);
            PG8_WAIT_V(6); PG8_BAR; PG8_MMA(1, 1, At, B1); PG8_BAR;
            PG8_LDB(B0, 1, 0); PG8_SCHED; PG8_LDA(At, 1, 0); PG8_STAGE(PG8_SA(0, 1), a2 + hstep, voffA);
            PG8_WAIT_L(8); PG8_BAR; PG8_WAIT_L(0); PG8_MMA(0, 0, At, B0); PG8_BAR; PG8_SCHED;
            PG8_LDB(B1, 1, 1); PG8_STAGE(PG8_SB(1, 0), b3, voffB);
            PG8_BAR; PG8_WAIT_L(0); PG8_MMA(0, 1, At, B1); PG8_BAR;
            PG8_LDA(At, 1, 1); PG8_STAGE(PG8_SA(1, 0), a3, voffA);
            PG8_BAR; PG8_WAIT_L(0); PG8_MMA(1, 0, At, B0); PG8_BAR; PG8_SCHED;
            PG8_STAGE(PG8_SB(1, 1), b3 + hstep, voffB);
            PG8_WAIT_V(6); PG8_BAR; PG8_MMA(1, 1, At, B1); PG8_BAR;
        }
        E(acc, cur, wr, wc, fr, fq);
        if (!has_next) break;
#pragma unroll
        for (int a = 0; a < 2; ++a)
#pragma unroll
            for (int b = 0; b < 2; ++b)
#pragma unroll
                for (int m = 0; m < 4; ++m)
#pragma unroll
                    for (int n = 0; n < 2; ++n) acc[a][b][m][n] = (f32x4){0.f, 0.f, 0.f, 0.f};
        cur = nxt; cA = nA; cB = nB; ++ui;
    }
    PG8_WAIT_V(0);
    if (wr == 0) PG8_BAR;
    PG8_BAR;
#undef PG8_SA
#undef PG8_SB
#undef PG8_STAGE
#undef PG8_LDA
#undef PG8_LDB
#undef PG8_MMA
#undef PG8_WAIT_V
#undef PG8_WAIT_L
#undef PG8_BAR
#undef PG8_SCHED
}
}

enum { EK_PROJ = 0, EK_MRG, EK_WO, EK_FFN, EK_DOWN, EK_NONE };

__device__ __forceinline__ float dpp_shr_add(float v, int) { return v; }
template <int CTRL> __device__ __forceinline__ float dpp_shr(float v) {
    return __builtin_bit_cast(float, __builtin_amdgcn_update_dpp(0, __builtin_bit_cast(int, v), CTRL, 0xf, 0xf, true));
}
__device__ __forceinline__ float row_scan16(float v) {
    v += dpp_shr<0x111>(v); v += dpp_shr<0x112>(v); v += dpp_shr<0x114>(v); v += dpp_shr<0x118>(v); return v;
}

template <int CTRL> __device__ __forceinline__ float dpp_shr1(float v) {
    return __builtin_bit_cast(float, __builtin_amdgcn_update_dpp(0x3f800000, __builtin_bit_cast(int, v), CTRL, 0xf, 0xf, false));
}
__device__ __forceinline__ float row_scanmul16(float v) {
    v *= dpp_shr1<0x111>(v); v *= dpp_shr1<0x112>(v); v *= dpp_shr1<0x114>(v); v *= dpp_shr1<0x118>(v); return v;
}
constexpr int LDS_BIAS = pg8::STAGE_BYTES + 16, LDS_LB = LDS_BIAS + DIN * 2, LDS_TOTAL = LDS_LB + DM * 4;
__device__ __forceinline__ f32x4 ldb4(const LAS half_t* p, int i) { const h4 v = *(const LAS h4*)(p + i); return (f32x4){(float)v[0], (float)v[1], (float)v[2], (float)v[3]}; }
struct Epi {
    int kind, hook_t;
    KP P;
    LAS unsigned char* lds;
    __device__ __forceinline__ void mid(f32x4 (&acc)[2][2][4][2], const pg8::Unit& u, int wr, int wc, int fr, int fq) const {
        unsigned char* ws = sopq(GP(P->ws));
        const int tid_ = otid(), lane_ = tid_ & 63, wid_ = tid_ >> 6;
        const int rowb = u.pm * 256 + (wid_ >> 2) * 64 + (lane_ & 15);
        const int c8 = (wid_ & 3) * 32 + (lane_ >> 4) * 8;
        const half_t* gsrc = kind == EK_MRG ? (const half_t*)GP(P->out) : (const half_t*)(ws + OFF_S2);
#pragma unroll
        for (int ai = 0; ai < 2; ++ai) {
            h8 gv[4][2];
#pragma unroll
            for (int m = 0; m < 4; ++m)
#pragma unroll
                for (int bj = 0; bj < 2; ++bj) gv[m][bj] = *(const h8*)(gsrc + (size_t)(rowb + ai * 128 + m * 16) * DM + u.pn * 256 + 128 * bj + c8);
            asm volatile("" ::: "memory");
#pragma unroll
            for (int m = 0; m < 4; ++m)
#pragma unroll
                for (int bj = 0; bj < 2; ++bj)
#pragma unroll
                    for (int j = 0; j < 4; ++j) { acc[ai][bj][m][0][j] *= (float)gv[m][bj][j]; acc[ai][bj][m][1][j] *= (float)gv[m][bj][4 + j]; }
            asm volatile("" ::: "memory");
        }
    }
    __device__ __forceinline__ void operator()(const f32x4 (&acc)[2][2][4][2], const pg8::Unit& u, int, int, int fr, int) const {
        unsigned char* ws = sopq(GP(P->ws));
        const int tid_ = otid(), lane = tid_ & 63, wid_ = tid_ >> 6;
        const int rowb = u.pm * 256 + (wid_ >> 2) * 64 + (lane & 15);
        const int c8 = (wid_ & 3) * 32 + (lane >> 4) * 8;
        fr = lane & 15;
        if (kind == EK_PROJ) {
            const LAS half_t* binp = (const LAS half_t*)(lds + LDS_BIAS);
            const int pn = u.pn;
            if (pn >= 8 && pn < 16) {
                const int h = pn - 8;
                half_t* Q = (half_t*)(ws + OFF_S4); half_t* F = (half_t*)(ws + OFF_S5); float* decay = (float*)(ws + OFF_DECAY);
                const LAS float* lbp = (const LAS float*)(lds + LDS_LB) + 128 * h + c8;
                const f32x4 lb0 = *(const LAS f32x4*)lbp, lb1 = *(const LAS f32x4*)(lbp + 4);
                const f32x4 bq0 = ldb4(binp, 256 * pn + c8), bq1 = ldb4(binp, 256 * pn + c8 + 4);
                const f32x4 bf0 = ldb4(binp, 256 * pn + 128 + c8), bf1 = ldb4(binp, 256 * pn + 128 + c8 + 4);
                const int src_last = ((lane | 15) << 2);
#pragma unroll
                for (int ai = 0; ai < 2; ++ai)
#pragma unroll
                    for (int m = 0; m < 4; ++m) {
                        const int row = rowb + ai * 128 + m * 16;
                        f32x4 qd[2], ke[2], dc[2];
#pragma unroll
                        for (int n = 0; n < 2; ++n)
#pragma unroll
                            for (int j = 0; j < 4; ++j) {
                                const float lb = n ? lb1[j] : lb0[j];
                                const float qv = acc[ai][0][m][n][j] + (n ? bq1[j] : bq0[j]);
                                const float fv = acc[ai][1][m][n][j] + (n ? bf1[j] : bf0[j]);
                                const float ef = __expf(-fv), sg = __builtin_amdgcn_rcpf(1.f + ef);
                                const float oml = 1.f - lb;
                                const float kk = oml * ef * sg;
                                const float pr = row_scanmul16(lb + oml * sg);
                                const float pl = __builtin_bit_cast(float, __builtin_amdgcn_ds_bpermute(src_last, __builtin_bit_cast(int, pr)));
                                qd[n][j] = qv * sigm(qv) * pr;
                                ke[n][j] = kk * pl * __builtin_amdgcn_rcpf(pr);
                                dc[n][j] = pl;
                            }
                        const size_t o = (size_t)row * DM + 128 * h + c8;
                        *(h8*)(Q + o) = pack8(qd[0], qd[1]);
                        *(h8*)(F + o) = pack8(ke[0], ke[1]);
                        if (fr == 15) { float* dp = decay + (size_t)(row >> 4) * DM + 128 * h + c8; *(f32x4*)dp = dc[0]; *(f32x4*)(dp + 4) = dc[1]; }
                    }
            } else if (pn >= 24) {
                const int j = pn - 24;
                half_t* R = (half_t*)GP(P->out); half_t* SB = (half_t*)GP(P->out) + (size_t)T * DM;
                const f32x4 ba0 = ldb4(binp, 256 * pn + c8), ba1 = ldb4(binp, 256 * pn + c8 + 4);
                const f32x4 bb0 = ldb4(binp, 256 * pn + 128 + c8), bb1 = ldb4(binp, 256 * pn + 128 + c8 + 4);
#pragma unroll
                for (int ai = 0; ai < 2; ++ai)
#pragma unroll
                    for (int m = 0; m < 4; ++m) {
                        const int row = rowb + ai * 128 + m * 16;
                        f32x4 rr[2], sb[2];
#pragma unroll
                        for (int n = 0; n < 2; ++n)
#pragma unroll
                            for (int jj = 0; jj < 4; ++jj) {
                                const float ea = __expf(-(acc[ai][0][m][n][jj] + (n ? ba1[jj] : ba0[jj]))), eb = __expf(-(acc[ai][1][m][n][jj] + (n ? bb1[jj] : bb0[jj])));
                                sb[n][jj] = __builtin_amdgcn_rcpf(1.f + eb);
                                rr[n][jj] = fminf((1.f + eb) * __builtin_amdgcn_rcpf(1.f + ea), 60000.f);
                            }
                        const size_t o = (size_t)row * DM + 128 * j + c8;
                        *(h8*)(R + o) = pack8(rr[0], rr[1]);
                        *(h8*)(SB + o) = pack8(sb[0], sb[1]);
                    }
            } else {
                half_t* dst; int act, colt;
                int ldd = DM;
                if (pn < 4) { dst = (half_t*)(ws + OFF_S2); act = 0; colt = pn * 256; ldd = YAB; }
                else if (pn < 8) { dst = (half_t*)(ws + OFF_S7); act = 0; colt = (pn - 4) * 256; }
                else if (pn < 20) { dst = (half_t*)(ws + OFF_S6); act = 1; colt = (pn - 16) * 256; }

                else { dst = (half_t*)(ws + OFF_S2) + DM; act = 2; colt = (pn - 20) * 256; ldd = YAB; }
#pragma unroll
                for (int bj = 0; bj < 2; ++bj) {
                    const f32x4 b0 = ldb4(binp, 256 * pn + 128 * bj + c8), b1 = ldb4(binp, 256 * pn + 128 * bj + c8 + 4);
#pragma unroll
                    for (int ai = 0; ai < 2; ++ai)
#pragma unroll
                        for (int m = 0; m < 4; ++m) {
                            const int row = rowb + ai * 128 + m * 16;
                            f32x4 r[2];
#pragma unroll
                            for (int n = 0; n < 2; ++n)
#pragma unroll
                                for (int j = 0; j < 4; ++j) {
                                    const float v = acc[ai][bj][m][n][j] + (n ? b1[j] : b0[j]);
                                    const float arg = act == 0 ? 1.5957691216057308f * (v + 0.044715f * v * v * v) : v;
                                    const float s = sigm(arg);
                                    r[n][j] = act == 1 ? v : (act == 3 ? s : v * s);
                                }
                            *(h8*)(dst + (size_t)row * ldd + colt + 128 * bj + c8) = pack8(r[0], r[1]);
                        }
                }
            }
        } else if (kind == EK_MRG) {
            const half_t* gate = (const half_t*)GP(P->out) + (size_t)T * DM;
            half_t* merged = (half_t*)(ws + OFF_S5);
#pragma unroll
            for (int ai = 0; ai < 2; ++ai) {
                h8 gv[4][2];
#pragma unroll
                for (int m = 0; m < 4; ++m)
#pragma unroll
                    for (int bj = 0; bj < 2; ++bj) gv[m][bj] = *(const h8*)(gate + (size_t)(rowb + ai * 128 + m * 16) * DM + u.pn * 256 + 128 * bj + c8);
                asm volatile("" ::: "memory");
#pragma unroll
                for (int m = 0; m < 4; ++m)
#pragma unroll
                    for (int bj = 0; bj < 2; ++bj) {
                        const size_t o = (size_t)(rowb + ai * 128 + m * 16) * DM + u.pn * 256 + 128 * bj + c8;
                        f32x4 r0, r1;
#pragma unroll
                        for (int j = 0; j < 4; ++j) { r0[j] = (float)gv[m][bj][j] * acc[ai][bj][m][0][j]; r1[j] = (float)gv[m][bj][4 + j] * acc[ai][bj][m][1][j]; }
                        *(h8*)(merged + o) = pack8(r0, r1);
                    }
                asm volatile("" ::: "memory");
            }
        } else if (kind == EK_WO) {
            half_t* z1 = (half_t*)(ws + OFF_S3);
            const float* st0 = (const float*)(ws + OFF_ST0);
            f32x4 g0[2], g1[2], b0[2], b1[2];
#pragma unroll
            for (int bj = 0; bj < 2; ++bj) { const int col = u.pn * 256 + 128 * bj + c8;
                g0[bj] = *(const f32x4*)(GP(P->ln0_g) + col); g1[bj] = *(const f32x4*)(GP(P->ln0_g) + col + 4); b0[bj] = *(const f32x4*)(GP(P->ln0_b) + col); b1[bj] = *(const f32x4*)(GP(P->ln0_b) + col + 4); }
#pragma unroll
            for (int ai = 0; ai < 2; ++ai)
#pragma unroll
                for (int mh = 0; mh < 2; ++mh) {
                    f32x2 ms[2]; f32x4 x0[2][2], x1[2][2];
#pragma unroll
                    for (int mm = 0; mm < 2; ++mm) { const int row = rowb + ai * 128 + (2 * mh + mm) * 16;
                        ms[mm] = *(const f32x2*)(st0 + 2 * row);
#pragma unroll
                        for (int bj = 0; bj < 2; ++bj) { const size_t o = (size_t)row * DM + u.pn * 256 + 128 * bj + c8; x0[mm][bj] = __builtin_nontemporal_load((const f32x4*)(GP(P->x) + o)); x1[mm][bj] = __builtin_nontemporal_load((const f32x4*)(GP(P->x) + o + 4)); } }
                    asm volatile("" ::: "memory");
#pragma unroll
                    for (int mm = 0; mm < 2; ++mm)
#pragma unroll
                        for (int bj = 0; bj < 2; ++bj) { const int m = 2 * mh + mm; const size_t o = (size_t)(rowb + ai * 128 + m * 16) * DM + u.pn * 256 + 128 * bj + c8;
                            f32x4 r0, r1;
#pragma unroll
                            for (int j = 0; j < 4; ++j) {
                                r0[j] = ALPHA * ((x0[mm][bj][j] - ms[mm][0]) * ms[mm][1] * g0[bj][j] + b0[bj][j]) + acc[ai][bj][m][0][j];
                                r1[j] = ALPHA * ((x1[mm][bj][j] - ms[mm][0]) * ms[mm][1] * g1[bj][j] + b1[bj][j]) + acc[ai][bj][m][1][j];
                            }
                            *(h8*)(z1 + o) = pack8(r0, r1); }
                    asm volatile("" ::: "memory");
                }
        } else if (kind == EK_FFN) {
            if (u.pn < 22) {
                half_t* hid = (half_t*)(ws + OFF_S5);
#pragma unroll
                for (int ai = 0; ai < 2; ++ai)
#pragma unroll
                    for (int m = 0; m < 4; ++m) {
                        const int row = rowb + ai * 128 + m * 16;
                        f32x4 r[2];
#pragma unroll
                        for (int n = 0; n < 2; ++n)
#pragma unroll
                            for (int j = 0; j < 4; ++j) { const float gt = acc[ai][0][m][n][j]; r[n][j] = gt * sigm(gt) * acc[ai][1][m][n][j]; }
                        *(h8*)(hid + (size_t)row * HPW + PLE + 128 * u.pn + c8) = pack8(r[0], r[1]);
                    }
            } else {
                half_t* pg = (half_t*)(ws + OFF_S2);
#pragma unroll
                for (int bj = 0; bj < 2; ++bj) {
                    const int col = (u.pn - 22) * 256 + 128 * bj + c8;
                    const f32x4 b0 = *(const f32x4*)(GP(P->bpg) + col), b1 = *(const f32x4*)(GP(P->bpg) + col + 4);
#pragma unroll
                    for (int ai = 0; ai < 2; ++ai)
#pragma unroll
                        for (int m = 0; m < 4; ++m) {
                            const int row = rowb + ai * 128 + m * 16;
                            f32x4 r[2];
#pragma unroll
                            for (int n = 0; n < 2; ++n)
#pragma unroll
                                for (int j = 0; j < 4; ++j) r[n][j] = sigm(acc[ai][bj][m][n][j] + (n ? b1[j] : b0[j]));
                            *(h8*)(pg + (size_t)row * DM + col) = pack8(r[0], r[1]);
                        }
                }
            }
        } else if (kind == EK_DOWN) {
            const half_t* h1 = (const half_t*)(ws + OFF_S1);
            half_t* z2 = (half_t*)(ws + OFF_S3);
#pragma unroll
            for (int ai = 0; ai < 2; ++ai) {
                h8 hv[4][2];
#pragma unroll
                for (int m = 0; m < 4; ++m)
#pragma unroll
                    for (int bj = 0; bj < 2; ++bj) hv[m][bj] = *(const h8*)(h1 + (size_t)(rowb + ai * 128 + m * 16) * DM + u.pn * 256 + 128 * bj + c8);
                asm volatile("" ::: "memory");
#pragma unroll
                for (int m = 0; m < 4; ++m)
#pragma unroll
                    for (int bj = 0; bj < 2; ++bj) {
                        const size_t o = (size_t)(rowb + ai * 128 + m * 16) * DM + u.pn * 256 + 128 * bj + c8;
                        f32x4 r0, r1;
#pragma unroll
                        for (int j = 0; j < 4; ++j) { r0[j] = acc[ai][bj][m][0][j] + ALPHA * (float)hv[m][bj][j]; r1[j] = acc[ai][bj][m][1][j] + ALPHA * (float)hv[m][bj][4 + j]; }
                        *(h8*)(z2 + o) = pack8(r0, r1);
                    }
                asm volatile("" ::: "memory");
            }
        }
    }
};

__device__ __forceinline__ void transpose_job(const float* src, int ld, int col0, half_t* dst, int dld, int dk0, int r0, int k0, float* tile, bool bf = false) {
    const int tid = otid();
    f32x4 tv[4];
#pragma unroll
    for (int i = 0; i < 4; ++i) { const int idx = tid + 512 * i, k = idx >> 4, n4 = idx & 15; tv[i] = __builtin_nontemporal_load((const f32x4*)(src + (size_t)(k0 + k) * ld + col0 + 4 * n4)); }
    asm volatile("" ::: "memory");
#pragma unroll
    for (int i = 0; i < 4; ++i) { const int idx = tid + 512 * i, k = idx >> 4, n4 = idx & 15; *(f32x4*)(tile + k * 68 + 4 * n4) = tv[i]; }
    __syncthreads();
#pragma unroll
    for (int i = 0; i < 2; ++i) { const int idx = tid + 512 * i, n = idx & 63, k8 = idx >> 6; h8 v; s8v vb;
#pragma unroll
        for (int j = 0; j < 8; ++j) { const float t = tile[(8 * k8 + j) * 68 + n]; v[j] = (half_t)t; vb[j] = (short)f2bf(t); }
        if (bf) *(s8v*)(dst + (size_t)(r0 + n) * dld + dk0 + k0 + 8 * k8) = vb; else *(h8*)(dst + (size_t)(r0 + n) * dld + dk0 + k0 + 8 * k8) = v; }
    __syncthreads();
}
__device__ __forceinline__ void ln_row(const float* xr, const float* g, const float* b, half_t* o16, float* o32, float* stat, int lane) {
    f32x4 v[4]; float s = 0.f;
#pragma unroll
    for (int j = 0; j < 4; ++j) { v[j] = *(const f32x4*)(xr + 4 * lane + 256 * j); s += (v[j][0] + v[j][1]) + (v[j][2] + v[j][3]); }
    const float mean = wave_sum(s) * (1.f / DM); float s2 = 0.f;
#pragma unroll
    for (int j = 0; j < 4; ++j) { v[j] = v[j] - mean; s2 += (v[j][0] * v[j][0] + v[j][1] * v[j][1]) + (v[j][2] * v[j][2] + v[j][3] * v[j][3]); }
    const float rstd = 1.f / sqrtf(wave_sum(s2) * (1.f / DM) + 1e-5f);
    if (stat && lane == 0) { stat[0] = mean; stat[1] = rstd; }
#pragma unroll
    for (int j = 0; j < 4; ++j) {
        const f32x4 gg = *(const f32x4*)(g + 4 * lane + 256 * j), bb = *(const f32x4*)(b + 4 * lane + 256 * j);
        const f32x4 y = v[j] * rstd * gg + bb;
        if (o16) { h4 hv; hv[0] = (half_t)y[0]; hv[1] = (half_t)y[1]; hv[2] = (half_t)y[2]; hv[3] = (half_t)y[3]; *(h4*)(o16 + 4 * lane + 256 * j) = hv; }
        if (o32) *(f32x4*)(o32 + 4 * lane + 256 * j) = y;
    }
}
__device__ __forceinline__ void ln_row16(const half_t* xr, const float* g, const float* b, half_t* o16, float* o32, int lane, unsigned short* ob16 = nullptr) {
    const h8 a = *(const h8*)(xr + 8 * lane), c = *(const h8*)(xr + 512 + 8 * lane);
    float v[16]; float s = 0.f;
#pragma unroll
    for (int i = 0; i < 8; ++i) { v[i] = (float)a[i]; v[8 + i] = (float)c[i]; s += v[i] + v[8 + i]; }
    const float mean = wave_sum(s) * (1.f / DM); float s2 = 0.f;
#pragma unroll
    for (int i = 0; i < 16; ++i) { v[i] -= mean; s2 += v[i] * v[i]; }
    const float rstd = 1.f / sqrtf(wave_sum(s2) * (1.f / DM) + 1e-5f);
#pragma unroll
    for (int hf = 0; hf < 2; ++hf) {
        const int col = 512 * hf + 8 * lane;
        const f32x4 g0 = *(const f32x4*)(g + col), g1 = *(const f32x4*)(g + col + 4), b0 = *(const f32x4*)(b + col), b1 = *(const f32x4*)(b + col + 4);
        f32x4 y0, y1;
#pragma unroll
        for (int j = 0; j < 4; ++j) { y0[j] = v[8 * hf + j] * rstd * g0[j] + b0[j]; y1[j] = v[8 * hf + 4 + j] * rstd * g1[j] + b1[j]; }
        if (o16) *(h8*)(o16 + col) = pack8(y0, y1);
        if (ob16) *(s8v*)(ob16 + col) = pack8b(y0, y1);
        if (o32) { *(f32x4*)(o32 + col) = y0; *(f32x4*)(o32 + col + 4) = y1; }
    }
}
__device__ __forceinline__ void phase_prep(KP P, unsigned char* lds) {
    unsigned char* ws = sopq(GP(P->ws));
    float* tile = (float*)lds;
    const int G = gridDim.x;
    constexpr int J_WIN = 1024, J_SQ = 128, J_GU = 832, J_WD = 352, J_PLE = 32, J_ALL = J_WIN + 3 * J_SQ + J_GU + J_WD + J_PLE;
    for (int j = blockIdx.x; j < J_ALL; j += G) {
        int r = j;
        if (r < J_WIN) { const int rt = r >> 3, kt = r & 7; transpose_job(GP(P->w_in), DIN, map_win(rt * 64), (half_t*)(ws + OFF_WIN), DM, 0, rt * 64, kt * 128, tile, BF_P1); continue; } r -= J_WIN;
        if (r < 3 * J_SQ) { const int w = r >> 7, rr = r & 127, rt = rr >> 3, kt = rr & 7;
            if (w < 2) transpose_job(w == 0 ? GP(P->w_a) : GP(P->w_b), DM, rt * 64, (half_t*)(ws + OFF_WA), YAB, w * DM, rt * 64, kt * 128, tile);
            else transpose_job(GP(P->w_o), DM, rt * 64, (half_t*)(ws + OFF_WO), DM, 0, rt * 64, kt * 128, tile);
            continue; } r -= 3 * J_SQ;
        if (r < J_GU) { const int rt = r >> 3, kt = r & 7, r0 = rt * 64; const float* src; int ld, col;
            if (r0 < 5632) { const int un = r0 >> 8, rho = r0 & 255; ld = DFF; if (rho < 128) { src = GP(P->wg); col = 128 * un + rho; } else { src = GP(P->wu); col = 128 * un + rho - 128; } }
            else { src = GP(P->wpg); ld = DM; col = r0 - 5632; }
            transpose_job(src, ld, col, (half_t*)(ws + OFF_WGU), DM, 0, r0, kt * 128, tile, BF_P9); continue; } r -= J_GU;
        if (r < J_WD) { const int rt = r / 22, kt = r % 22; transpose_job(GP(P->wd), DM, rt * 64, (half_t*)(ws + OFF_WD), HPW, PLE, rt * 64, kt * 128, tile); continue; } r -= J_WD;
        { const int rt = r >> 1, kt = r & 1; transpose_job(GP(P->wple), DM, rt * 64, (half_t*)(ws + OFF_WD), HPW, 0, rt * 64, kt * 128, tile); }
    }
    const int tidp = otid(); const int gt = blockIdx.x * 512 + tidp;
    if (gt < DIN) ((float*)(ws + OFF_BINP))[gt] = GP(P->b_in)[map_win(gt)];
    if (gt < DM) ((float*)(ws + OFF_LB))[gt] = sigm(GP(P->lbl)[gt] - GP(P->lbl)[DM + gt]);
    const int lane = tidp & 63, gw = blockIdx.x * 8 + (tidp >> 6);
    for (int row = gw; row < T; row += 2 * G * 8) {
        const int row2 = row + G * 8;
        const float* x0 = GP(P->x) + (size_t)row * DM; const float* x1 = GP(P->x) + (size_t)(row2 < T ? row2 : row) * DM;
        f32x4 va[4], vb[4]; float sa = 0.f, sb = 0.f;
#pragma unroll
        for (int j = 0; j < 4; ++j) { va[j] = __builtin_nontemporal_load((const f32x4*)(x0 + 4 * lane + 256 * j)); vb[j] = __builtin_nontemporal_load((const f32x4*)(x1 + 4 * lane + 256 * j)); }
#pragma unroll
        for (int j = 0; j < 4; ++j) { sa += (va[j][0] + va[j][1]) + (va[j][2] + va[j][3]); sb += (vb[j][0] + vb[j][1]) + (vb[j][2] + vb[j][3]); }
        const float ma = wave_sum(sa) * (1.f / DM), mb = wave_sum(sb) * (1.f / DM); float qa = 0.f, qb = 0.f;
#pragma unroll
        for (int j = 0; j < 4; ++j) { va[j] = va[j] - ma; vb[j] = vb[j] - mb;
            qa += (va[j][0] * va[j][0] + va[j][1] * va[j][1]) + (va[j][2] * va[j][2] + va[j][3] * va[j][3]);
            qb += (vb[j][0] * vb[j][0] + vb[j][1] * vb[j][1]) + (vb[j][2] * vb[j][2] + vb[j][3] * vb[j][3]); }
        const float ra = 1.f / sqrtf(wave_sum(qa) * (1.f / DM) + 1e-5f), rb = 1.f / sqrtf(wave_sum(qb) * (1.f / DM) + 1e-5f);
        float* st = (float*)(ws + OFF_ST0);
        if (lane == 0) { st[2 * row] = ma; st[2 * row + 1] = ra; if (row2 < T) { st[2 * row2] = mb; st[2 * row2 + 1] = rb; } }
        half_t* o0 = (half_t*)(ws + OFF_S1) + (size_t)row * DM; half_t* o1 = (half_t*)(ws + OFF_S1) + (size_t)row2 * DM;
#pragma unroll
        for (int j = 0; j < 4; ++j) {
            const f32x4 gg = *(const f32x4*)(GP(P->ln0_g) + 4 * lane + 256 * j), bb = *(const f32x4*)(GP(P->ln0_b) + 4 * lane + 256 * j);
            const f32x4 ya = va[j] * ra * gg + bb, yb = vb[j] * rb * gg + bb;
            h4 ha, hb;
#pragma unroll
            for (int k = 0; k < 4; ++k) {
                if (BF_P1) { ha[k] = __builtin_bit_cast(half_t, f2bf(ya[k])); hb[k] = __builtin_bit_cast(half_t, f2bf(yb[k])); }
                else { ha[k] = (half_t)ya[k]; hb[k] = (half_t)yb[k]; }
            }
            *(h4*)(o0 + 4 * lane + 256 * j) = ha;
            if (row2 < T) *(h4*)(o1 + 4 * lane + 256 * j) = hb;
        }
    }
}

__device__ __forceinline__ void gmlp_item(KP P, unsigned char* lds, int item, bool dry = false) {
    unsigned char* ws = sopq(GP(P->ws));
    const int tid = otid(), lane = tid & 63, w = tid >> 6, l15 = lane & 15, quad = lane >> 4;
    const int tok0 = item * 128;
    half_t* U = (half_t*)(ws + OFF_S2); const half_t* V = (const half_t*)(ws + OFF_S7);
    half_t* Ws = (half_t*)lds; half_t* vnT = (half_t*)(lds + 34816); float* mean = (float*)(lds + 69632); float* rstd = mean + 128;
    for (int r4 = 0; r4 < 16; r4 += 4) {
        h8 a[4], b[4];
#pragma unroll
        for (int r = 0; r < 4; ++r) { const half_t* vr = V + (size_t)(tok0 + 16 * w + r4 + r) * DM; a[r] = *(const h8*)(vr + lane * 8); b[r] = *(const h8*)(vr + 512 + lane * 8); }
        asm volatile("" ::: "memory");
#pragma unroll
        for (int r = 0; r < 4; ++r) {
            const int t = 16 * w + r4 + r;
            float s = 0.f, s2 = 0.f;
#pragma unroll
            for (int i = 0; i < 8; ++i) { const float x0 = (float)a[r][i], x1 = (float)b[r][i]; s += x0 + x1; s2 += x0 * x0 + x1 * x1; }
            s = wave_sum(s); s2 = wave_sum(s2);
            const float mu = s * (1.f / DM), var = fmaxf(s2 * (1.f / DM) - mu * mu, 0.f);
            if (lane == 0) { mean[t] = mu; rstd[t] = 1.f / sqrtf(var + 1e-5f); }
        }
    }
    __syncthreads();
    for (int g = 0; g < 8; ++g) {
        f32x4 wvv[8];
#pragma unroll
        for (int i = 0; i < 8; ++i) { const int idx = tid + 512 * i, t = idx >> 5, s4 = idx & 31; wvv[i] = *(const f32x4*)(GP(P->gm_ws) + ((size_t)(g * 128 + t)) * 128 + 4 * s4); }
        h8 vvv[4];
#pragma unroll
        for (int i = 0; i < 4; ++i) { const int idx = i * 8 + w, cc8 = idx & 15, s = (idx >> 4) * 64 + lane; vvv[i] = *(const h8*)(V + (size_t)(tok0 + s) * DM + g * 128 + 8 * cc8); }
        asm volatile("" ::: "memory");
#pragma unroll
        for (int i = 0; i < 8; ++i) {
            const int idx = tid + 512 * i, t = idx >> 5, s4 = idx & 31;
            f32x4 wv = wvv[i];
            if ((t >> 6) < ((4 * s4) >> 6)) wv = (f32x4){0.f, 0.f, 0.f, 0.f};
            h4 hv; hv[0] = (half_t)wv[0]; hv[1] = (half_t)wv[1]; hv[2] = (half_t)wv[2]; hv[3] = (half_t)wv[3];
            *(h4*)(Ws + t * 136 + 4 * s4) = hv;
        }
#pragma unroll
        for (int i = 0; i < 4; ++i) {
            const int idx = i * 8 + w, cc8 = idx & 15, s = (idx >> 4) * 64 + lane;
            const h8 v = vvv[i];
            const float mu = mean[s], rs = rstd[s];
            const f32x4 ga = *(const f32x4*)(GP(P->gm_g) + g * 128 + 8 * cc8), gb = *(const f32x4*)(GP(P->gm_g) + g * 128 + 8 * cc8 + 4);
            const f32x4 ba = *(const f32x4*)(GP(P->gm_b) + g * 128 + 8 * cc8), bb = *(const f32x4*)(GP(P->gm_b) + g * 128 + 8 * cc8 + 4);
#pragma unroll
            for (int k = 0; k < 8; ++k) {
                const float gg = k < 4 ? ga[k & 3] : gb[k & 3], bt = k < 4 ? ba[k & 3] : bb[k & 3];
                vnT[(8 * cc8 + k) * 136 + s] = (half_t)(((float)v[k] - mu) * rs * gg + bt);
            }
        }
        __syncthreads();
        const int nks = w < 4 ? 2 : 4;
        h8 Bf[4];
#pragma unroll
        for (int ks = 0; ks < 4; ++ks) Bf[ks] = *(const h8*)(Ws + (16 * w + l15) * 136 + 32 * ks + 8 * quad);
        const int t = 16 * w + l15;
        const float bias = GP(P->gm_bs)[g * 128 + t];
        h4 uvv[8];
#pragma unroll
        for (int ct = 0; ct < 8; ++ct) uvv[ct] = *(const h4*)(U + (size_t)(tok0 + t) * YAB + g * 128 + 16 * ct + 4 * quad);
#pragma unroll
        for (int ct = 0; ct < 8; ++ct) {
            f32x4 acc = (f32x4){0.f, 0.f, 0.f, 0.f};
#pragma unroll
            for (int ks = 0; ks < 4; ++ks) if (ks < nks) {
                const h8 Af = *(const h8*)(vnT + (16 * ct + l15) * 136 + 32 * ks + 8 * quad);
                acc = __builtin_amdgcn_mfma_f32_16x16x32_f16(Af, Bf[ks], acc, 0, 0, 0);
            }
            half_t* up = U + (size_t)(tok0 + t) * YAB + g * 128 + 16 * ct + 4 * quad;
            const h4 uv = uvv[ct]; h4 y;
#pragma unroll
            for (int j = 0; j < 4; ++j) y[j] = (half_t)((float)uv[j] * (acc[j] + bias));
            if (!dry) *(h4*)up = y;
        }
        __syncthreads();
    }
}

constexpr int HB_QD = 0, HB_QDB = 4352, HB_KDEC = 8704, HB_KET = 13056, HB_VT = 18176, HB_DEC = 23296, HB_OB = 23808, HB_SIZE = 32256;
constexpr int SEGL = 512, NSEG = 16, NCH = 32, NITEM = 32 * NSEG;

template <bool EMIT>
__device__ __forceinline__ void hgrn_item(KP P, unsigned char* lds, int item, bool dry = false) {
    unsigned char* ws = sopq(GP(P->ws));
    const int tid = otid(), lane = tid & 63, w = tid >> 6, l15 = lane & 15, quad = lane >> 4;
    const int bh = item / NSEG, seg = item % NSEG, b = bh >> 3, h = bh & 7;
    const int tokbase = b * 8192 + seg * SEGL, colbase = h * 128;
    const half_t* Q = (const half_t*)(ws + OFF_S4); const half_t* F = (const half_t*)(ws + OFF_S5); const half_t* I = (const half_t*)(ws + OFF_S6);
    half_t* Gp = (half_t*)(ws + OFF_S2) + DM;
    const float* decay = (const float*)(ws + OFF_DECAY);
    float* Sbuf = (float*)(ws + OFF_S1) + (size_t)item * 16384;
    const int half = tid >> 8, pp = tid & 255, st = pp & 15, sc8 = pp >> 4;
    f32x4 S[8];
#pragma unroll
    for (int dt = 0; dt < 8; ++dt) {
        if (EMIT) {
#pragma unroll
            for (int r = 0; r < 4; ++r) S[dt][r] = Sbuf[((w * 8 + dt) * 4 + r) * 64 + lane];
        } else S[dt] = (f32x4){0.f, 0.f, 0.f, 0.f};
    }
    float dprod = 1.f;
    h8 r0, r1; f32x4 rd0, rd1; h2 gcur[2], gprev[2];
    { const float one = __int_as_float(vopq(0x3f800000)); rd0 = rd1 = (f32x4){one, one, one, one}; const half_t hz = (half_t)__int_as_float(vopq(0)); r1 = r0 = (h8)hz; }
    { const half_t hz = (half_t)__int_as_float(vopq(0)); gcur[0] = gcur[1] = gprev[0] = gprev[1] = (h2)hz; }
    const float og0 = GP(P->hg_g)[colbase + 2 * lane], og1 = GP(P->hg_g)[colbase + 2 * lane + 1];
    {
        const size_t o = (size_t)(tokbase + st) * DM + colbase + 8 * sc8;
        if (half == 0) { r0 = *(const h8*)(Q + o); r1 = *(const h8*)(F + o); const float* dp = decay + (size_t)(tokbase >> 4) * DM + colbase + 8 * sc8; rd0 = *(const f32x4*)dp; rd1 = *(const f32x4*)(dp + 4); }
        else r0 = *(const h8*)(I + o);
    }
#pragma unroll 1
    for (int c = 0; c < NCH; ++c) {
        unsigned char* base = lds + (c & 1) * HB_SIZE;
        if (half == 0) {
            *(h8*)(base + HB_QD + (st * 136 + 8 * sc8) * 2) = r0;
            s8v qb, kb;
#pragma unroll
            for (int i = 0; i < 8; ++i) {
                qb[i] = (short)f2bf((float)r0[i]);
                const float dv = i < 4 ? rd0[i & 3] : rd1[i & 3];
                kb[i] = (short)f2bf((float)r1[i] * __builtin_amdgcn_rcpf(dv));
                *(half_t*)(base + HB_KET + ((8 * sc8 + i) * 20 + st) * 2) = r1[i];
            }
            *(s8v*)(base + HB_QDB + (st * 136 + 8 * sc8) * 2) = qb;
            *(s8v*)(base + HB_KDEC + (st * 136 + 8 * sc8) * 2) = kb;
            if (st == 0) { float* dq = (float*)(base + HB_DEC) + 8 * sc8; *(f32x4*)dq = rd0; *(f32x4*)(dq + 4) = rd1; }
        } else {
#pragma unroll
            for (int i = 0; i < 8; ++i) *(half_t*)(base + HB_VT + ((8 * sc8 + i) * 20 + st) * 2) = r0[i];
        }
        if (EMIT) {
            gprev[0] = gcur[0]; gprev[1] = gcur[1];
#pragma unroll
            for (int tt = 0; tt < 2; ++tt) gcur[tt] = *(const h2*)(Gp + (size_t)(tokbase + c * 16 + 2 * w + tt) * YAB + colbase + 2 * lane);
        }
        if (c + 1 < NCH) {
            const size_t o = (size_t)(tokbase + (c + 1) * 16 + st) * DM + colbase + 8 * sc8;
            if (half == 0) { r0 = *(const h8*)(Q + o); r1 = *(const h8*)(F + o); const float* dp = decay + (size_t)((tokbase >> 4) + c + 1) * DM + colbase + 8 * sc8; rd0 = *(const f32x4*)dp; rd1 = *(const f32x4*)(dp + 4); }
            else r0 = *(const h8*)(I + o);
        }
        __syncthreads();
        if (!EMIT) { if (tid < 128) dprod *= ((const float*)(base + HB_DEC))[tid]; }
        if (EMIT && c >= 1) {
            const float* ob = (const float*)(lds + ((c - 1) & 1) * HB_SIZE + HB_OB);
#pragma unroll
            for (int tt = 0; tt < 2; ++tt) {
                const int t = 2 * w + tt;
                const f32x2 v = *(const f32x2*)(ob + t * 132 + 2 * lane);
                const float ss = wave_sum(v[0] * v[0] + v[1] * v[1]);
                const float rr = 1.f / sqrtf(ss * (1.f / 128.f) + 1e-6f);
                const float g0 = (float)gprev[tt][0], g1 = (float)gprev[tt][1];
                h2 y; y[0] = (half_t)(v[0] * rr * og0 * g0); y[1] = (half_t)(v[1] * rr * og1 * g1);
                if (!dry) *(h2*)(Gp + (size_t)(tokbase + (c - 1) * 16 + t) * YAB + colbase + 2 * lane) = y;
            }
        }
        const h4 vB = *(const h4*)(base + HB_VT + ((16 * w + l15) * 20 + 4 * quad) * 2);
        if (EMIT) {
            f32x4 sc = (f32x4){0.f, 0.f, 0.f, 0.f};
#pragma unroll
            for (int ks = 0; ks < 4; ++ks) {
                const s8v ka = *(const s8v*)(base + HB_KDEC + (l15 * 136 + 32 * ks + 8 * quad) * 2);
                const s8v qb = *(const s8v*)(base + HB_QDB + (l15 * 136 + 32 * ks + 8 * quad) * 2);
                sc = __builtin_amdgcn_mfma_f32_16x16x32_bf16(__builtin_bit_cast(__attribute__((ext_vector_type(8))) __bf16, ka), __builtin_bit_cast(__attribute__((ext_vector_type(8))) __bf16, qb), sc, 0, 0, 0);
            }
            h4 scA;
#pragma unroll
            for (int r = 0; r < 4; ++r) scA[r] = (half_t)((4 * quad + r) <= l15 ? sc[r] : 0.f);
            f32x4 o = __builtin_amdgcn_mfma_f32_16x16x16f16(scA, vB, (f32x4){0.f, 0.f, 0.f, 0.f}, 0, 0, 0); MFMA16_KEEP(scA, vB);
#pragma unroll
            for (int ks = 0; ks < 4; ++ks) {
                const h4 qa = *(const h4*)(base + HB_QD + (l15 * 136 + 32 * ks + 4 * quad) * 2);
                const h4 qc = *(const h4*)(base + HB_QD + (l15 * 136 + 32 * ks + 16 + 4 * quad) * 2);
                h8 qA, sB;
#pragma unroll
                for (int j = 0; j < 4; ++j) { qA[j] = qa[j]; qA[4 + j] = qc[j]; sB[j] = (half_t)S[2 * ks][j]; sB[4 + j] = (half_t)S[2 * ks + 1][j]; }
                o = __builtin_amdgcn_mfma_f32_16x16x32_f16(qA, sB, o, 0, 0, 0);
            }
            float* ob = (float*)(base + HB_OB);
#pragma unroll
            for (int r = 0; r < 4; ++r) ob[(4 * quad + r) * 132 + 16 * w + l15] = o[r];
        }
#pragma unroll
        for (int dt = 0; dt < 8; ++dt) {
            const f32x4 dv = *(const f32x4*)(base + HB_DEC + (16 * dt + 4 * quad) * 4);
            const h4 kA = *(const h4*)(base + HB_KET + ((16 * dt + l15) * 20 + 4 * quad) * 2);
            S[dt] = __builtin_amdgcn_mfma_f32_16x16x16f16(kA, vB, S[dt] * dv, 0, 0, 0); MFMA16_KEEP(kA, vB);
        }
    }
    if (EMIT) {
        __syncthreads();
        const float* ob = (const float*)(lds + ((NCH - 1) & 1) * HB_SIZE + HB_OB);
#pragma unroll
        for (int tt = 0; tt < 2; ++tt) {
            const int t = 2 * w + tt;
            const f32x2 v = *(const f32x2*)(ob + t * 132 + 2 * lane);
            const float ss = wave_sum(v[0] * v[0] + v[1] * v[1]);
            const float rr = 1.f / sqrtf(ss * (1.f / 128.f) + 1e-6f);
            const float g0 = (float)gcur[tt][0], g1 = (float)gcur[tt][1];
            h2 y; y[0] = (half_t)(v[0] * rr * og0 * g0); y[1] = (half_t)(v[1] * rr * og1 * g1);
            if (!dry) *(h2*)(Gp + (size_t)(tokbase + (NCH - 1) * 16 + t) * YAB + colbase + 2 * lane) = y;
        }
    } else {
#pragma unroll
        for (int dt = 0; dt < 8; ++dt)
#pragma unroll
            for (int r = 0; r < 4; ++r) if (!dry) Sbuf[((w * 8 + dt) * 4 + r) * 64 + lane] = S[dt][r];
        if (tid < 128 && !dry) ((float*)(ws + OFF_DSEG))[(size_t)item * 128 + tid] = dprod;
    }
    __syncthreads();
}


__device__ __forceinline__ void hgrn_pairA(KP P, unsigned char* lds, int item0, int item1) {
    unsigned char* ws = sopq(GP(P->ws));
    const int tid = otid(), lane = tid & 63, w = tid >> 6, l15 = lane & 15, quad = lane >> 4;
    const half_t* F = (const half_t*)(ws + OFF_S5); const half_t* I = (const half_t*)(ws + OFF_S6);
    const float* decay = (const float*)(ws + OFF_DECAY);
    const int half = tid >> 8, pp = tid & 255, st = pp & 15, sc8 = pp >> 4;
    int tokbase[2], colbase[2];
#pragma unroll
    for (int j = 0; j < 2; ++j) { const int item = j ? item1 : item0, bh = item / NSEG, seg = item % NSEG; tokbase[j] = (bh >> 3) * 8192 + seg * SEGL; colbase[j] = (bh & 7) * 128; }
    f32x4 S[2][8];
#pragma unroll
    for (int j = 0; j < 2; ++j)
#pragma unroll
        for (int dt = 0; dt < 8; ++dt) S[j][dt] = (f32x4){0.f, 0.f, 0.f, 0.f};
    float dprod[2] = {1.f, 1.f};
    h8 r[2]; f32x4 rd0[2], rd1[2];
    { const float one = __int_as_float(vopq(0x3f800000)); const half_t hz = (half_t)__int_as_float(vopq(0));
#pragma unroll
      for (int j = 0; j < 2; ++j) { rd0[j] = rd1[j] = (f32x4){one, one, one, one}; r[j] = (h8)hz; } }
#pragma unroll
    for (int j = 0; j < 2; ++j) {
        const size_t o = (size_t)(tokbase[j] + st) * DM + colbase[j] + 8 * sc8;
        if (half == 0) { r[j] = *(const h8*)(F + o); const float* dp = decay + (size_t)(tokbase[j] >> 4) * DM + colbase[j] + 8 * sc8; rd0[j] = *(const f32x4*)dp; rd1[j] = *(const f32x4*)(dp + 4); }
        else r[j] = *(const h8*)(I + o);
    }
#pragma unroll 1
    for (int c = 0; c < NCH; ++c) {
#pragma unroll
        for (int j = 0; j < 2; ++j) {
            unsigned char* base = lds + (2 * j + (c & 1)) * HB_SIZE;
            if (half == 0) {
#pragma unroll
                for (int i = 0; i < 8; ++i) *(half_t*)(base + HB_KET + ((8 * sc8 + i) * 20 + st) * 2) = r[j][i];
                if (st == 0) { float* dq = (float*)(base + HB_DEC) + 8 * sc8; *(f32x4*)dq = rd0[j]; *(f32x4*)(dq + 4) = rd1[j]; }
            } else {
#pragma unroll
                for (int i = 0; i < 8; ++i) *(half_t*)(base + HB_VT + ((8 * sc8 + i) * 20 + st) * 2) = r[j][i];
            }
        }
        if (c + 1 < NCH) {
#pragma unroll
            for (int j = 0; j < 2; ++j) {
                const size_t o = (size_t)(tokbase[j] + (c + 1) * 16 + st) * DM + colbase[j] + 8 * sc8;
                if (half == 0) { r[j] = *(const h8*)(F + o); const float* dp = decay + (size_t)((tokbase[j] >> 4) + c + 1) * DM + colbase[j] + 8 * sc8; rd0[j] = *(const f32x4*)dp; rd1[j] = *(const f32x4*)(dp + 4); }
                else r[j] = *(const h8*)(I + o);
            }
        }
        __syncthreads();
#pragma unroll
        for (int j = 0; j < 2; ++j) {
            unsigned char* base = lds + (2 * j + (c & 1)) * HB_SIZE;
            if (tid < 128) dprod[j] *= ((const float*)(base + HB_DEC))[tid];
            const h4 vB = *(const h4*)(base + HB_VT + ((16 * w + l15) * 20 + 4 * quad) * 2);
#pragma unroll
            for (int dt = 0; dt < 8; ++dt) {
                const f32x4 dv = *(const f32x4*)(base + HB_DEC + (16 * dt + 4 * quad) * 4);
                const h4 kA = *(const h4*)(base + HB_KET + ((16 * dt + l15) * 20 + 4 * quad) * 2);
                S[j][dt] = __builtin_amdgcn_mfma_f32_16x16x16f16(kA, vB, S[j][dt] * dv, 0, 0, 0); MFMA16_KEEP(kA, vB);
            }
        }
    }
#pragma unroll
    for (int j = 0; j < 2; ++j) {
        const int item = j ? item1 : item0;
        float* Sbuf = (float*)(ws + OFF_S1) + (size_t)item * 16384;
#pragma unroll
        for (int dt = 0; dt < 8; ++dt)
#pragma unroll
            for (int rr = 0; rr < 4; ++rr) Sbuf[((w * 8 + dt) * 4 + rr) * 64 + lane] = S[j][dt][rr];
        if (tid < 128) ((float*)(ws + OFF_DSEG))[(size_t)item * 128 + tid] = dprod[j];
    }
    __syncthreads();
}

__device__ __forceinline__ void phase_scan(KP P) {
    unsigned char* ws = sopq(GP(P->ws));
    float* Sb = (float*)(ws + OFF_S1); const float* Ds = (const float*)(ws + OFF_DSEG);
    const int N = gridDim.x * 512;
    for (int e4 = blockIdx.x * 512 + otid(); e4 < 32 * 4096; e4 += N) {
        const int bh = e4 >> 12, idx = (e4 & 4095) * 4;
        const int ln = idx & 63, r = (idx >> 6) & 3, dt = (idx >> 8) & 7, d = 16 * dt + 4 * (ln >> 4) + r;
        f32x4 run = (f32x4){0.f, 0.f, 0.f, 0.f};
#pragma unroll 1
        for (int s0 = 0; s0 < NSEG; s0 += 8) {
            f32x4 loc[8]; float dd[8];
#pragma unroll
            for (int k = 0; k < 8; ++k) {
                const int seg = s0 + k;
                if (seg < NSEG - 1) { loc[k] = *(const f32x4*)(Sb + ((size_t)(bh * NSEG + seg)) * 16384 + idx); dd[k] = Ds[(size_t)(bh * NSEG + seg) * 128 + d]; }
                else { loc[k] = (f32x4){0.f, 0.f, 0.f, 0.f}; dd[k] = 0.f; }
            }
            asm volatile("" ::: "memory");
#pragma unroll
            for (int k = 0; k < 8; ++k) {
                const int seg = s0 + k;
                *(f32x4*)(Sb + ((size_t)(bh * NSEG + seg)) * 16384 + idx) = run;
                run = run * dd[k] + loc[k];
            }
            asm volatile("" ::: "memory");
        }
    }
}

__device__ __forceinline__ void phase_ln(KP P, const half_t* src, const float* g, const float* b, half_t* o16, float* o32, unsigned short* ob16 = nullptr) {
    constexpr int NR = 4;
    const int tidl = otid(); const int lane = tidl & 63, gw = blockIdx.x * 8 + (tidl >> 6), stride = gridDim.x * 8;
    for (int row0 = gw; row0 < T; row0 += NR * stride) {
        h8 a[NR], c[NR];
#pragma unroll
        for (int r = 0; r < NR; ++r) { const int row = row0 + r * stride < T ? row0 + r * stride : row0; const half_t* xr = src + (size_t)row * DM; a[r] = __builtin_nontemporal_load((const h8*)(xr + 8 * lane)); c[r] = __builtin_nontemporal_load((const h8*)(xr + 512 + 8 * lane)); }
        asm volatile("" ::: "memory");
#pragma unroll
        for (int r = 0; r < NR; ++r) {
            const int row = row0 + r * stride;
            if (row < T) {
                float v[16]; float s1 = 0.f;
#pragma unroll
                for (int i = 0; i < 8; ++i) { v[i] = (float)a[r][i]; v[8 + i] = (float)c[r][i]; s1 += v[i] + v[8 + i]; }
                const float mean = wave_sum(s1) * (1.f / DM); float s2 = 0.f;
#pragma unroll
                for (int i = 0; i < 16; ++i) { v[i] -= mean; s2 += v[i] * v[i]; }
                const float rstd = 1.f / sqrtf(wave_sum(s2) * (1.f / DM) + 1e-5f);
#pragma unroll
                for (int hf = 0; hf < 2; ++hf) {
                    const int col = 512 * hf + 8 * lane;
                    const f32x4 g0 = *(const f32x4*)(g + col), g1 = *(const f32x4*)(g + col + 4), b0 = *(const f32x4*)(b + col), b1 = *(const f32x4*)(b + col + 4);
                    f32x4 y0, y1;
#pragma unroll
                    for (int j = 0; j < 4; ++j) { y0[j] = v[8 * hf + j] * rstd * g0[j] + b0[j]; y1[j] = v[8 * hf + 4 + j] * rstd * g1[j] + b1[j]; }
                    if (o16) *(h8*)(o16 + (size_t)row * DM + col) = pack8(y0, y1);
                    if (ob16) *(s8v*)(ob16 + (size_t)row * DM + col) = pack8b(y0, y1);
                    if (o32) { *(f32x4*)(o32 + (size_t)row * DM + col) = y0; *(f32x4*)(o32 + (size_t)row * DM + col + 4) = y1; }
                }
            }
        }
    }
}

#define XB_TMO      128
#define XB_XCNT(j)  (256  + 64 * (j))
#define XB_XSUB(j)  (1280 + 64 * (j))
#define XB_XGEN(j)  (2304 + 64 * (j))
#define XB_TOP      3328
#define XB_TOPGEN   3392
#define XCD_BAR_WORDS 3456
#define XB_SPIN_CAP (1u << 18)
__device__ __forceinline__ unsigned xb_ld(unsigned* p)              { return __hip_atomic_load(p, __ATOMIC_RELAXED, __HIP_MEMORY_SCOPE_AGENT); }
__device__ __forceinline__ unsigned xb_add(unsigned* p, unsigned v) { return __hip_atomic_fetch_add(p, v, __ATOMIC_RELAXED, __HIP_MEMORY_SCOPE_AGENT); }
__device__ __forceinline__ unsigned xb_xcc_id() { return (unsigned)__builtin_amdgcn_s_getreg((3 << 11) | 20) & 0xFu; }
#define XB_SPIN(cond, bar) do { unsigned _sp = 0; while (cond) { __builtin_amdgcn_s_sleep(1); \
    if ((++_sp & 255u) == 0u) { if (xb_ld(&(bar)[XB_TMO])) break; if (_sp > XB_SPIN_CAP) { atomicAdd(&(bar)[XB_TMO], 1u); break; } } } } while (0)
struct XcdBarrier { unsigned* bar; unsigned x; volatile LAS unsigned* st; };
__device__ __forceinline__ XcdBarrier xcd_barrier_post(unsigned* bar, volatile LAS unsigned* st) {
    XcdBarrier b; b.bar = bar; b.x = xb_xcc_id(); b.st = st;
    if (otid() == 0) (void)xb_add(&bar[XB_XCNT(b.x)], 1u);
    return b;
}
__device__ __forceinline__ void xcd_barrier_complete(unsigned* bar, unsigned x, unsigned& nloc, unsigned& nx) {
    const unsigned G = gridDim.x * gridDim.y * gridDim.z;
    unsigned sum, cnt, mine, sp = 0u;
    for (;;) {
        sum = 0u; cnt = 0u; mine = 0u;
#pragma unroll
        for (unsigned j = 0; j < 16; ++j) { const unsigned c = xb_ld(&bar[XB_XCNT(j)]); sum += c; cnt += (c > 0u) ? 1u : 0u; mine = (j == x) ? c : mine; }
        if (sum == G) break;
        __builtin_amdgcn_s_sleep(1);
        if ((++sp & 255u) == 0u) { if (xb_ld(&bar[XB_TMO])) break; if (sp > XB_SPIN_CAP) { atomicAdd(&bar[XB_TMO], 1u); break; } }
    }
    nloc = mine > 0u ? mine : 1u; nx = cnt > 0u ? cnt : 1u;
}
__device__ __forceinline__ void xcd_barrier(const XcdBarrier& b) {
    asm volatile("s_waitcnt vmcnt(0)" ::: "memory");
    __syncthreads();
    if (otid() == 0) {
        unsigned* bar = b.bar;
        __builtin_amdgcn_s_waitcnt(0);
        unsigned nloc = b.st[0], nx = b.st[1];
        if (nloc == 0u) { xcd_barrier_complete(bar, b.x, nloc, nx); b.st[0] = nloc; b.st[1] = nx; }
        const unsigned old = xb_add(&bar[XB_XSUB(b.x)], 1u);
        const unsigned gen = old / nloc;
        if (old + 1u == (gen + 1u) * nloc) {
            __builtin_amdgcn_fence(__ATOMIC_RELEASE, "agent");
            asm volatile("s_waitcnt vmcnt(0)" ::: "memory");
            const unsigned og = xb_add(&bar[XB_TOP], 1u);
            const unsigned tg = og / nx;
            if (og + 1u == (tg + 1u) * nx) xb_add(&bar[XB_TOPGEN], 1u);
            else XB_SPIN(xb_ld(&bar[XB_TOPGEN]) == tg, bar);
            __builtin_amdgcn_fence(__ATOMIC_ACQUIRE, "agent");
            xb_add(&bar[XB_XGEN(b.x)], 1u);
            asm volatile("s_waitcnt vmcnt(0)" ::: "memory");
        } else {
            XB_SPIN(xb_ld(&bar[XB_XGEN(b.x)]) == gen, bar);
            __builtin_amdgcn_fence(__ATOMIC_ACQUIRE, "agent");
            asm volatile("s_waitcnt vmcnt(0)" ::: "memory");
        }
    }
    __syncthreads();
}

__global__ void __launch_bounds__(512, 2) mega(Params Pk) {
    KP P = kp_get();
    extern __shared__ __attribute__((aligned(16))) unsigned char shm[];
    cg::grid_group grid = cg::this_grid();
    unsigned char* ws = sopq(GP(P->ws));
    const int G = gridDim.x;
    volatile LAS unsigned* xst = (volatile LAS unsigned*)((LAS unsigned char*)shm + pg8::STAGE_BYTES);
#if USE_XCD
    if (otid() == 0) { xst[0] = 0u; xst[1] = 0u; }
    __syncthreads();
    (void)xcd_barrier_post((unsigned*)(ws + OFF_BAR), xst);
    if (P->ph1 < 0) grid.sync();
#endif
#pragma unroll 1
    for (int pi = P->ph0; pi < P->ph1; ++pi) {
        const int ph = PROG[pi];
        P = kp_get();
        unsigned char* ws = sopq(GP(P->ws));
        int gk = -1, hk = -1, bfk = 0; pg8::Gemm g; g.M = T; g.A = nullptr; g.Bt = nullptr; g.N = DM; g.K = DM;
        switch (ph) {
            case 1: gk = EK_PROJ; bfk = BF_P1; g.A = (const half_t*)(ws + OFF_S1); g.Bt = (const half_t*)(ws + OFF_WIN); g.N = DIN; g.K = DM; break;
            case 5: gk = EK_MRG; hk = 16; g.A = (const half_t*)(ws + OFF_S2); g.Bt = (const half_t*)(ws + OFF_WA); g.K = YAB; break;
            case 7: gk = EK_WO; g.A = (const half_t*)(ws + OFF_S5); g.Bt = (const half_t*)(ws + OFF_WO); break;
            case 9: gk = EK_FFN; bfk = BF_P9; g.A = (const half_t*)(ws + (BF_P9 ? OFF_S4 : OFF_S1)); g.Bt = (const half_t*)(ws + OFF_WGU); g.N = 6656; break;
            case 11: gk = EK_DOWN; hk = 4; g.A = (const half_t*)(ws + OFF_S5); g.Bt = (const half_t*)(ws + OFF_WD); g.K = HPW; break;
            default: break;
        }
        if (gk >= 0) {
            if (gk == EK_PROJ) {
                const int t0 = otid(); const float* bsrc = (const float*)(ws + OFF_BINP); const float* lsrc = (const float*)(ws + OFF_LB);
                LAS half_t* bl = (LAS half_t*)((LAS unsigned char*)shm + LDS_BIAS); LAS float* ll = (LAS float*)((LAS unsigned char*)shm + LDS_LB);
                for (int i = t0; i < DIN; i += 512) bl[i] = (half_t)bsrc[i];
                for (int i = t0; i < DM; i += 512) ll[i] = lsrc[i];
                __syncthreads();
            }
            pg8::StaticOrder S; S.init(g.M, g.N, G, blockIdx.x);
            Epi E; E.kind = gk; E.hook_t = hk; E.P = P; E.lds = (LAS unsigned char*)shm;
            if (bfk) pg8::gemm_phase<Epi, true>((LAS unsigned char*)shm, g, S, E); else pg8::gemm_phase<Epi>((LAS unsigned char*)shm, g, S, E);
        } else if (ph == 0) {
            phase_prep(P, shm);
        } else if (ph == 2) {
            for (int it = blockIdx.x; it < 256; it += G) gmlp_item(P, shm, it);
            for (int it = blockIdx.x; it < NITEM; it += 2 * G) {
                const int it1 = it + G; const bool v0 = (it % NSEG) != NSEG - 1, v1 = it1 < NITEM && (it1 % NSEG) != NSEG - 1;
                if (v0 && v1) hgrn_pairA(P, shm, it, it1);
                else { if (v0) hgrn_item<false>(P, shm, it); if (v1) hgrn_item<false>(P, shm, it1); }
            }
        } else if (ph == 3) {
            phase_scan(P);
        } else if (ph == 4) {
            for (int it = blockIdx.x; it < NITEM; it += G) hgrn_item<true>(P, shm, it);
        } else if (ph == 8) {
            phase_ln(P, (const half_t*)(ws + OFF_S3), GP(P->ln1_g), GP(P->ln1_b), (half_t*)(ws + OFF_S1), nullptr, BF_P9 ? (unsigned short*)(ws + OFF_S4) : nullptr);
            half_t* p16 = (half_t*)(ws + OFF_S5);
            {
                const int i0 = blockIdx.x * 512 + otid(), str = G * 512;
                for (int it = 0; it < 8; it += 4) {
                    f32x4 pa[4], pb[4];
#pragma unroll
                    for (int k = 0; k < 4; ++k) { const int i = i0 + (it + k) * str; const int ic = i < T * PLE / 8 ? i : i0; pa[k] = __builtin_nontemporal_load((const f32x4*)(GP(P->p) + (size_t)ic * 8)); pb[k] = __builtin_nontemporal_load((const f32x4*)(GP(P->p) + (size_t)ic * 8 + 4)); }
                    asm volatile("" ::: "memory");
#pragma unroll
                    for (int k = 0; k < 4; ++k) { const int i = i0 + (it + k) * str; if (i < T * PLE / 8) *(h8*)(p16 + (size_t)(i >> 5) * HPW + (i & 31) * 8) = pack8(pa[k], pb[k]); }
                }
                for (int i = i0 + 8 * str; i < T * PLE / 8; i += str) {
                    const f32x4 a = *(const f32x4*)(GP(P->p) + (size_t)i * 8), b = *(const f32x4*)(GP(P->p) + (size_t)i * 8 + 4);
                    *(h8*)(p16 + (size_t)(i >> 5) * HPW + (i & 31) * 8) = pack8(a, b);
                }
            }
        } else if (ph == 12) {
            phase_ln(P, (const half_t*)(ws + OFF_S3), GP(P->ln2_g), GP(P->ln2_b), nullptr, GP(P->out));
        }
        if (pi + 1 < P->ph1) {
#if USE_XCD
            { XcdBarrier xb; xb.bar = (unsigned*)(ws + OFF_BAR); xb.x = xb_xcc_id(); xb.st = xst; xcd_barrier(xb); }
#else
            grid.sync();
#endif
        }
    }
}

extern "C" void kernel_launch(void* const* d_in, const int* in_sizes, int n_in, void* d_out, int out_size, void* d_ws, size_t ws_size, hipStream_t stream) {
    static int grid = 0;
    constexpr int LDS_BYTES = LDS_TOTAL;
    if (grid == 0) {
        if (n_in != 25 || ws_size < WS_NEED || out_size != T * DM) { fprintf(stderr, "kernel_launch: unexpected shapes n_in %d ws %zu out %d\n", n_in, ws_size, out_size); grid = -1; return; }
        int dev = 0, cus = 0, per_cu = 0;
        hipGetDevice(&dev);
        hipDeviceGetAttribute(&cus, hipDeviceAttributeMultiprocessorCount, dev);
        hipFuncSetAttribute((const void*)mega, hipFuncAttributeMaxDynamicSharedMemorySize, LDS_BYTES);
        hipOccupancyMaxActiveBlocksPerMultiprocessor(&per_cu, (const void*)mega, 512, LDS_BYTES);
        if (per_cu < 1) { fprintf(stderr, "kernel_launch: occupancy query says %d blocks per CU\n", per_cu); per_cu = 1; }
        (void)hipGetLastError();
        grid = cus;
    }
    if (grid < 0) return;
    Params P{};
#if USE_XCD && !MK_MULTI
    (void)hipMemsetAsync((unsigned char*)d_ws + OFF_BAR, 0, XCD_BAR_WORDS * 4, stream);
#endif
    const float** f = (const float**)&P;
    for (int i = 0; i < 25; ++i) f[i] = (const float*)d_in[i];
    P.out = (float*)d_out; P.ws = (unsigned char*)d_ws;
#if MK_MULTI
    for (int ph = 0; ph < NPH; ++ph) {
        P.ph0 = ph; P.ph1 = ph + 1;
        void* args[] = {&P};
        hipError_t e = hipLaunchCooperativeKernel((const void*)mega, dim3(grid), dim3(512), args, LDS_BYTES, stream);
        if (e != hipSuccess) fprintf(stderr, "launch failed: %s\n", hipGetErrorString(e));
    }
#else
    P.ph0 = 0; P.ph1 = NPH;
    void* args[] = {&P};
    hipError_t e = hipLaunchCooperativeKernel((const void*)mega, dim3(grid), dim3(512), args, LDS_BYTES, stream);
    if (e != hipSuccess) fprintf(stderr, "cooperative launch failed: %s (grid %d)\n", hipGetErrorString(e), grid);
#endif
}
```

```cpp
#include <hip/hip_runtime.h>
#include <hip/hip_cooperative_groups.h>
#include <cstdio>
namespace cg = cooperative_groups;

#ifndef BF_P1
#define BF_P1 1
#endif
#ifndef BF_P9
#define BF_P9 1
#endif
#ifndef USE_XCD
#define USE_XCD 1
#endif
#ifndef MK_MULTI
#define MK_MULTI 0
#endif

#define LAS __attribute__((address_space(3)))
typedef _Float16 half_t;
typedef _Float16 h8 __attribute__((ext_vector_type(8)));
typedef _Float16 h4 __attribute__((ext_vector_type(4)));
typedef _Float16 h2 __attribute__((ext_vector_type(2)));
typedef short s8v __attribute__((ext_vector_type(8)));
typedef float f32x4 __attribute__((ext_vector_type(4)));
typedef __bf16 bf8v __attribute__((ext_vector_type(8)));
typedef float f32x2 __attribute__((ext_vector_type(2)));

constexpr int T = 32768, DM = 1024, DIN = 8192, DFF = 2816, PLE = 256, YAB = 2048, HPW = 3072;
constexpr float ALPHA = 1.189207115002721f;
constexpr size_t MiB = (size_t)1 << 20;
constexpr size_t OFF_WIN = 0, OFF_WA = 16 * MiB, OFF_WB = 18 * MiB, OFF_WO = 20 * MiB, OFF_WGU = 22 * MiB, OFF_WD = 35 * MiB, OFF_WPLE = 40 * MiB + 512 * 1024;
constexpr size_t OFF_BINP = 41 * MiB, OFF_LB = 41 * MiB + 32768, OFF_ST0 = 41 * MiB + 65536, OFF_DSEG = 42 * MiB, OFF_DECAY = 43 * MiB;
constexpr size_t OFF_BAR = 52 * MiB;
constexpr size_t OFF_S1 = 64 * MiB, OFF_S2 = 128 * MiB, OFF_S3 = 192 * MiB, OFF_S4 = 256 * MiB, OFF_S5 = 320 * MiB, OFF_S6 = 384 * MiB, OFF_S7 = 448 * MiB, OFF_P16 = 496 * MiB;
constexpr size_t WS_NEED = 512 * MiB;
#ifndef PROG_LIST
#define PROG_LIST 0, 1, 2, 3, 4, 5, 7, 8, 9, 11, 12
#endif
__device__ const int PROG[] = {PROG_LIST};
constexpr int PROG_HOST[] = {PROG_LIST};
constexpr int NPH = sizeof(PROG_HOST) / sizeof(int);

struct Params {
    const float *x, *p, *ln0_g, *ln0_b, *w_in, *b_in, *gm_g, *gm_b, *gm_ws, *gm_bs, *lbl, *hg_g, *w_a, *w_b, *w_o, *ln1_g, *ln1_b, *wg, *wu, *wd, *wple, *wpg, *bpg, *ln2_g, *ln2_b;
    float* out; unsigned char* ws;
    int ph0, ph1;
};

__device__ __forceinline__ int otid() { int t; asm volatile("v_mov_b32 %0, %1" : "=v"(t) : "v"((int)threadIdx.x)); return t; }
__device__ __forceinline__ int vopq(int x) { int t; asm volatile("v_mov_b32 %0, %1" : "=v"(t) : "v"(x)); return t; }
#define GAS __attribute__((address_space(1)))
template <class Tp> __device__ __forceinline__ Tp* GP(Tp* p) { return (Tp*)(Tp GAS*)p; }
typedef const Params __attribute__((address_space(4)))* KP;
__device__ __forceinline__ KP kp_get() { unsigned long long v; asm volatile("s_mov_b64 %0, %1" : "=s"(v) : "s"((unsigned long long)__builtin_amdgcn_kernarg_segment_ptr())); return (KP)v; }
__device__ __forceinline__ unsigned char* sopq(unsigned char* p) { unsigned long long v; asm volatile("s_mov_b64 %0, %1" : "=s"(v) : "s"((unsigned long long)p)); return (unsigned char*)(unsigned char GAS*)v; }
__device__ __forceinline__ float sigm(float x) { return __builtin_amdgcn_rcpf(1.f + __expf(-x)); }
__device__ __forceinline__ float wave_sum(float v) {
#pragma unroll
    for (int o = 1; o < 64; o <<= 1) v += __shfl_xor(v, o);
    return v;
}
__device__ __forceinline__ unsigned short f2bf(float f) { unsigned u = __float_as_uint(f); u += 0x7FFFu + ((u >> 16) & 1u); return (unsigned short)(u >> 16); }
__device__ __forceinline__ h8 pack8(f32x4 a, f32x4 b) { h8 v; v[0] = (half_t)a[0]; v[1] = (half_t)a[1]; v[2] = (half_t)a[2]; v[3] = (half_t)a[3]; v[4] = (half_t)b[0]; v[5] = (half_t)b[1]; v[6] = (half_t)b[2]; v[7] = (half_t)b[3]; return v; }
__device__ __forceinline__ s8v pack8b(f32x4 a, f32x4 b) { s8v v;
#pragma unroll
    for (int i = 0; i < 4; ++i) { v[i] = (short)f2bf(a[i]); v[4 + i] = (short)f2bf(b[i]); }
    return v; }
#define MFMA16_KEEP(a, b) asm volatile("" :: "v"(a), "v"(b))
__device__ __forceinline__ int map_win(int r) {
    if (r < 2048 || (r >= 4096 && r < 6144)) return r;
    const int rho = r & 255;
    if (r >= 6144) { const int j = (r - 6144) >> 8; return rho < 128 ? 6144 + 128 * j + rho : 7168 + 128 * j + rho - 128; }
    const int h = (r - 2048) >> 8;
    return rho < 128 ? 2048 + 128 * h + rho : 3072 + 128 * h + rho - 128;
}

namespace pg8 {
constexpr int BM = 256, BK = 64, HALF = 128, HTB = HALF * BK * 2, STAGE_BYTES = 8 * HTB, NXCD = 8, WGM = 8;
__host__ __device__ __forceinline__ int lds_byte(int r, int c) { const int st = (r >> 4) * 2 + (c >> 5), rr = r & 15, cc = c & 31, ob = rr * 64 + cc * 2; return st * 1024 + (ob ^ (((ob >> 9) & 1) << 5)); }
__host__ __device__ __forceinline__ void stage_rc(int b, int& R, int& C) { const int st = b / 1024, sb = b % 1024, swz = sb ^ (((sb >> 9) & 1) << 5); R = (st >> 1) * 16 + swz / 64; C = (st & 1) * 32 + (swz % 64) / 2; }
__host__ __device__ __forceinline__ int perm32(int rho) { const int n = rho >> 4, i = rho & 15; return 8 * (i >> 2) + 4 * n + (i & 3); }
struct Unit { int pm, pn; };
struct Gemm { const half_t* A; const half_t* Bt; int M, N, K; };
struct StaticOrder {
    int nM, nN, nwg, G, c;
    __host__ __device__ void init(int M, int N, int G_, int c_) { nM = M / BM; nN = N / BM; nwg = nM * nN; G = G_; c = c_; }
    __host__ __device__ bool next(int i, Unit& u) const {
        const long L = (long)i * G + c; if (L >= nwg) return false;
        int wgid = (int)L; { const int q = nwg / NXCD, r = nwg % NXCD, xcd = wgid % NXCD, off = wgid / NXCD; wgid = (xcd < r ? xcd * (q + 1) : r * (q + 1) + (xcd - r) * q) + off; }
        const int nig = WGM * nN, gid = wgid / nig, fm = gid * WGM, gsz = (nM - fm) < WGM ? (nM - fm) : WGM;
        u.pm = fm + ((wgid % nig) % gsz); u.pn = (wgid % nig) / gsz; return true;
    }
};

template <class Epi, bool BF = false>
__device__ __forceinline__ void gemm_phase(LAS unsigned char* lds, const Gemm g, const StaticOrder& S, const Epi& E) {
    const int tid = otid(), wid = __builtin_amdgcn_readfirstlane(tid >> 6), lane = tid & 63, wr = wid >> 2, wc = wid & 3, fr = lane & 15, fq = lane >> 4;
    const int K = g.K, nt = K / BK;
    unsigned voffA[2], voffB[2];
#pragma unroll
    for (int i = 0; i < 2; ++i) { int R, C; stage_rc(tid * 16 + i * 8192, R, C); const int Rb = (R & ~31) + perm32(R & 31);
        voffA[i] = (unsigned)(R * K + C) * 2u; voffB[i] = (unsigned)(Rb * K + C) * 2u; }
    const size_t kstep = (size_t)(BK * 2);
    const size_t hstep = (size_t)HALF * K * 2;
    const size_t tstep = 2 * hstep;
    const unsigned ldsw = (unsigned)wid * 1024u;
    const int aoff = lds_byte(wr * 64 + fr, fq * 8), boff = lds_byte(wc * 32 + fr, fq * 8);
#define PG8_SA(b, h) (((b) * 2 + (h)) * HTB)
#define PG8_SB(b, h) ((4 + (b) * 2 + (h)) * HTB)
#define PG8_STAGE(bufoff, gbase, voff) do { _Pragma("unroll") for (int _i = 0; _i < 2; ++_i) \
        __builtin_amdgcn_global_load_lds((const unsigned*)((const char*)(gbase) + (voff)[_i]), (LAS unsigned*)(lds + (bufoff) + ldsw + _i * 8192), 16, 0, 0); } while (0)
#define PG8_LDA(dst, b, h) do { _Pragma("unroll") for (int m = 0; m < 4; ++m) _Pragma("unroll") for (int k = 0; k < 2; ++k) dst[m][k] = *(const LAS h8*)(lds + PG8_SA(b, h) + aoff + m * 2048 + k * 1024); } while (0)
#define PG8_LDB(dst, b, h) do { _Pragma("unroll") for (int n = 0; n < 2; ++n) _Pragma("unroll") for (int k = 0; k < 2; ++k) dst[n][k] = *(const LAS h8*)(lds + PG8_SB(b, h) + boff + n * 2048 + k * 1024); } while (0)
#define PG8_MMA(ai, bj, At, Bt) do { __builtin_amdgcn_s_setprio(1); _Pragma("unroll") for (int m = 0; m < 4; ++m) _Pragma("unroll") for (int n = 0; n < 2; ++n) _Pragma("unroll") for (int k = 0; k < 2; ++k) \
        acc[ai][bj][m][n] = BF ? __builtin_amdgcn_mfma_f32_16x16x32_bf16(__builtin_bit_cast(bf8v, Bt[n][k]), __builtin_bit_cast(bf8v, At[m][k]), acc[ai][bj][m][n], 0, 0, 0) \
                               : __builtin_amdgcn_mfma_f32_16x16x32_f16(Bt[n][k], At[m][k], acc[ai][bj][m][n], 0, 0, 0); __builtin_amdgcn_s_setprio(0); } while (0)
#define PG8_WAIT_V(n) asm volatile("s_waitcnt vmcnt(" #n ")" ::: "memory")
#define PG8_WAIT_L(n) asm volatile("s_waitcnt lgkmcnt(" #n ")" ::: "memory")
#define PG8_BAR __builtin_amdgcn_s_barrier()
#define PG8_SCHED __builtin_amdgcn_sched_barrier(0)
    Unit cur, nxt; int ui = 0;
    if (!S.next(0, cur)) return;
    f32x4 acc[2][2][4][2];
#pragma unroll
    for (int a = 0; a < 2; ++a)
#pragma unroll
        for (int b = 0; b < 2; ++b)
#pragma unroll
            for (int m = 0; m < 4; ++m)
#pragma unroll
                for (int n = 0; n < 2; ++n) acc[a][b][m][n] = (f32x4){0.f, 0.f, 0.f, 0.f};
    h8 At[4][2], B0[2][2], B1[2][2];
    const char* cA = (const char*)sopq((unsigned char*)g.A) + (size_t)cur.pm * tstep; const char* cB = (const char*)sopq((unsigned char*)g.Bt) + (size_t)cur.pn * tstep;
    PG8_STAGE(PG8_SB(0, 0), cB, voffB); PG8_STAGE(PG8_SA(0, 0), cA, voffA); PG8_STAGE(PG8_SB(0, 1), cB + hstep, voffB); PG8_STAGE(PG8_SA(0, 1), cA + hstep, voffA);
    if (wr == 1) PG8_BAR;
    PG8_WAIT_V(4); PG8_BAR;
    PG8_STAGE(PG8_SB(1, 0), cB + kstep, voffB); PG8_STAGE(PG8_SA(1, 0), cA + kstep, voffA); PG8_STAGE(PG8_SB(1, 1), cB + hstep + kstep, voffB);
    PG8_WAIT_V(6); PG8_BAR;
    for (;;) {
        const bool has_next = S.next(ui + 1, nxt);
        const char* nA = has_next ? (const char*)sopq((unsigned char*)g.A) + (size_t)nxt.pm * tstep : cA; const char* nB = has_next ? (const char*)sopq((unsigned char*)g.Bt) + (size_t)nxt.pn * tstep : cB;
        for (int t = 0; t < nt; t += 2) {
            if (t == E.hook_t) E.mid(acc, cur, wr, wc, fr, fq);
            const bool last = (t == nt - 2);
            const char* a1 = cA + (size_t)(t + 1) * kstep;
            const char* a2 = last ? nA : cA + (size_t)(t + 2) * kstep; const char* b2 = last ? nB : cB + (size_t)(t + 2) * kstep;
            const char* a3 = a2 + kstep; const char* b3 = b2 + kstep;
            PG8_LDB(B0, 0, 0); PG8_SCHED; PG8_LDA(At, 0, 0); PG8_STAGE(PG8_SA(1, 1), a1 + hstep, voffA);
            PG8_WAIT_L(8); PG8_BAR; PG8_WAIT_L(0); PG8_MMA(0, 0, At, B0); PG8_BAR; PG8_SCHED;
            PG8_LDB(B1, 0, 1); PG8_STAGE(PG8_SB(0, 0), b2, voffB);
            PG8_BAR; PG8_WAIT_L(0); PG8_MMA(0, 1, At, B1); PG8_BAR;
            PG8_LDA(At, 0, 1); PG8_STAGE(PG8_SA(0, 0), a2, voffA);
            PG8_BAR; PG8_WAIT_L(0); PG8_MMA(1, 0, At, B0); PG8_BAR; PG8_SCHED;
            PG8_STAGE(PG8_SB(0, 1), b2 + hstep, voffB);
            PG8_WAIT_V(6); PG8_BAR; PG8_MMA(1, 1, At, B1); PG8_BAR;
            PG8_LDB(B0, 1, 0); PG8_SCHED; PG8_LDA(At, 1, 0); PG8_STAGE(PG8_SA(0, 1), a2 + hstep, voffA);
            PG8_WAIT_L(8); PG8_BAR; PG8_WAIT_L(0); PG8_MMA(0, 0, At, B0); PG8_BAR; PG8_SCHED;
            PG8_LDB(B1, 1, 1); PG8_STAGE(PG8_SB(1, 0), b3, voffB);
            PG8_BAR; PG8_WAIT_L(0); PG8_MMA(0, 1, At, B1); PG8_BAR;
            PG8_LDA(At, 1, 1); PG8_STAGE(PG8_SA(1, 0), a3, voffA);
            PG8_BAR; PG8_WAIT_L(0); PG8_MMA(1, 0, At, B0); PG8_BAR; PG8_SCHED;
            PG8_STAGE(PG8_SB(1, 1), b3 + hstep, voffB);
            PG8_WAIT_V(6); PG8_BAR; PG8_MMA(1, 1, At, B1); PG8_BAR;
        }
        E(acc, cur, wr, wc, fr, fq);
        if (!has_next) break;
#pragma unroll
        for (int a = 0; a < 2; ++a)
#pragma unroll
            for (int b = 0; b < 2; ++b)
#pragma unroll
                for (int m = 0; m < 4; ++m)
#pragma unroll
                    for (int n = 0; n < 2; ++n) acc[a][b][m][n] = (f32x4){0.f, 0.f, 0.f, 0.f};
        cur = nxt; cA = nA; cB = nB; ++ui;
    }
    PG8_WAIT_V(0);
    if (wr == 0) PG8_BAR;
    PG8_BAR;
#undef PG8_SA
#undef PG8_SB
#undef PG8_STAGE
#undef PG8_LDA
#undef PG8_LDB
#undef PG8_MMA
#undef PG8_WAIT_V
#undef PG8_WAIT_L
#undef PG8_BAR
#undef PG8_SCHED
}
}

enum { EK_PROJ = 0, EK_MRG, EK_WO, EK_FFN, EK_DOWN, EK_NONE };

__device__ __forceinline__ float dpp_shr_add(float v, int) { return v; }
template <int CTRL> __device__ __forceinline__ float dpp_shr(float v) {
    return __builtin_bit_cast(float, __builtin_amdgcn_update_dpp(0, __builtin_bit_cast(int, v), CTRL, 0xf, 0xf, true));
}
__device__ __forceinline__ float row_scan16(float v) {
    v += dpp_shr<0x111>(v); v += dpp_shr<0x112>(v); v += dpp_shr<0x114>(v); v += dpp_shr<0x118>(v); return v;
}

template <int CTRL> __device__ __forceinline__ float dpp_shr1(float v) {
    return __builtin_bit_cast(float, __builtin_amdgcn_update_dpp(0x3f800000, __builtin_bit_cast(int, v), CTRL, 0xf, 0xf, false));
}
__device__ __forceinline__ float row_scanmul16(float v) {
    v *= dpp_shr1<0x111>(v); v *= dpp_shr1<0x112>(v); v *= dpp_shr1<0x114>(v); v *= dpp_shr1<0x118>(v); return v;
}
constexpr int LDS_BIAS = pg8::STAGE_BYTES + 16, LDS_LB = LDS_BIAS + DIN * 2, LDS_TOTAL = LDS_LB + DM * 4;
__device__ __forceinline__ f32x4 ldb4(const LAS half_t* p, int i) { const h4 v = *(const LAS h4*)(p + i); return (f32x4){(float)v[0], (float)v[1], (float)v[2], (float)v[3]}; }
struct Epi {
    int kind, hook_t;
    KP P;
    LAS unsigned char* lds;
    __device__ __forceinline__ void mid(f32x4 (&acc)[2][2][4][2], const pg8::Unit& u, int wr, int wc, int fr, int fq) const {
        unsigned char* ws = sopq(GP(P->ws));
        const int tid_ = otid(), lane_ = tid_ & 63, wid_ = tid_ >> 6;
        const int rowb = u.pm * 256 + (wid_ >> 2) * 64 + (lane_ & 15);
        const int c8 = (wid_ & 3) * 32 + (lane_ >> 4) * 8;
        const half_t* gsrc = kind == EK_MRG ? (const half_t*)GP(P->out) : (const half_t*)(ws + OFF_S2);
#pragma unroll
        for (int ai = 0; ai < 2; ++ai) {
            h8 gv[4][2];
#pragma unroll
            for (int m = 0; m < 4; ++m)
#pragma unroll
                for (int bj = 0; bj < 2; ++bj) gv[m][bj] = *(const h8*)(gsrc + (size_t)(rowb + ai * 128 + m * 16) * DM + u.pn * 256 + 128 * bj + c8);
            asm volatile("" ::: "memory");
#pragma unroll
            for (int m = 0; m < 4; ++m)
#pragma unroll
                for (int bj = 0; bj < 2; ++bj)
#pragma unroll
                    for (int j = 0; j < 4; ++j) { acc[ai][bj][m][0][j] *= (float)gv[m][bj][j]; acc[ai][bj][m][1][j] *= (float)gv[m][bj][4 + j]; }
            asm volatile("" ::: "memory");
        }
    }
    __device__ __forceinline__ void operator()(const f32x4 (&acc)[2][2][4][2], const pg8::Unit& u, int, int, int fr, int) const {
        unsigned char* ws = sopq(GP(P->ws));
        const int tid_ = otid(), lane = tid_ & 63, wid_ = tid_ >> 6;
        const int rowb = u.pm * 256 + (wid_ >> 2) * 64 + (lane & 15);
        const int c8 = (wid_ & 3) * 32 + (lane >> 4) * 8;
        fr = lane & 15;
        if (kind == EK_PROJ) {
            const LAS half_t* binp = (const LAS half_t*)(lds + LDS_BIAS);
            const int pn = u.pn;
            if (pn >= 8 && pn < 16) {
                const int h = pn - 8;
                half_t* Q = (half_t*)(ws + OFF_S4); half_t* F = (half_t*)(ws + OFF_S5); float* decay = (float*)(ws + OFF_DECAY);
                const LAS float* lbp = (const LAS float*)(lds + LDS_LB) + 128 * h + c8;
                const f32x4 lb0 = *(const LAS f32x4*)lbp, lb1 = *(const LAS f32x4*)(lbp + 4);
                const f32x4 bq0 = ldb4(binp, 256 * pn + c8), bq1 = ldb4(binp, 256 * pn + c8 + 4);
                const f32x4 bf0 = ldb4(binp, 256 * pn + 128 + c8), bf1 = ldb4(binp, 256 * pn + 128 + c8 + 4);
                const int src_last = ((lane | 15) << 2);
#pragma unroll
                for (int ai = 0; ai < 2; ++ai)
#pragma unroll
                    for (int m = 0; m < 4; ++m) {
                        const int row = rowb + ai * 128 + m * 16;
                        f32x4 qd[2], ke[2], dc[2];
#pragma unroll
                        for (int n = 0; n < 2; ++n)
#pragma unroll
                            for (int j = 0; j < 4; ++j) {
                                const float lb = n ? lb1[j] : lb0[j];
                                const float qv = acc[ai][0][m][n][j] + (n ? bq1[j] : bq0[j]);
                                const float fv = acc[ai][1][m][n][j] + (n ? bf1[j] : bf0[j]);
                                const float ef = __expf(-fv), sg = __builtin_amdgcn_rcpf(1.f + ef);
                                const float oml = 1.f - lb;
                                const float kk = oml * ef * sg;
                                const float pr = row_scanmul16(lb + oml * sg);
                                const float pl = __builtin_bit_cast(float, __builtin_amdgcn_ds_bpermute(src_last, __builtin_bit_cast(int, pr)));
                                qd[n][j] = qv * sigm(qv) * pr;
                                ke[n][j] = kk * pl * __builtin_amdgcn_rcpf(pr);
                                dc[n][j] = pl;
                            }
                        const size_t o = (size_t)row * DM + 128 * h + c8;
                        *(h8*)(Q + o) = pack8(qd[0], qd[1]);
                        *(h8*)(F + o) = pack8(ke[0], ke[1]);
                        if (fr == 15) { float* dp = decay + (size_t)(row >> 4) * DM + 128 * h + c8; *(f32x4*)dp = dc[0]; *(f32x4*)(dp + 4) = dc[1]; }
                    }
            } else if (pn >= 24) {
                const int j = pn - 24;
                half_t* R = (half_t*)GP(P->out); half_t* SB = (half_t*)GP(P->out) + (size_t)T * DM;
                const f32x4 ba0 = ldb4(binp, 256 * pn + c8), ba1 = ldb4(binp, 256 * pn + c8 + 4);
                const f32x4 bb0 = ldb4(binp, 256 * pn + 128 + c8), bb1 = ldb4(binp, 256 * pn + 128 + c8 + 4);
#pragma unroll
                for (int ai = 0; ai < 2; ++ai)
#pragma unroll
                    for (int m = 0; m < 4; ++m) {
                        const int row = rowb + ai * 128 + m * 16;
                        f32x4 rr[2], sb[2];
#pragma unroll
                        for (int n = 0; n < 2; ++n)
#pragma unroll
                            for (int jj = 0; jj < 4; ++jj) {
                                const float ea = __expf(-(acc[ai][0][m][n][jj] + (n ? ba1[jj] : ba0[jj]))), eb = __expf(-(acc[ai][1][m][n][jj] + (n ? bb1[jj] : bb0[jj])));
                                sb[n][jj] = __builtin_amdgcn_rcpf(1.f + eb);
                                rr[n][jj] = fminf((1.f + eb) * __builtin_amdgcn_rcpf(1.f + ea), 60000.f);
                            }
                        const size_t o = (size_t)row * DM + 128 * j + c8;
                        *(h8*)(R + o) = pack8(rr[0], rr[1]);
                        *(h8*)(SB + o) = pack8(sb[0], sb[1]);
                    }
            } else {
                half_t* dst; int act, colt;
                int ldd = DM;
                if (pn < 4) { dst = (half_t*)(ws + OFF_S2); act = 0; colt = pn * 256; ldd = YAB; }
                else if (pn < 8) { dst = (half_t*)(ws + OFF_S7); act = 0; colt = (pn - 4) * 256; }
                else if (pn < 20) { dst = (half_t*)(ws + OFF_S6); act = 1; colt = (pn - 16) * 256; }

                else { dst = (half_t*)(ws + OFF_S2) + DM; act = 2; colt = (pn - 20) * 256; ldd = YAB; }
#pragma unroll
                for (int bj = 0; bj < 2; ++bj) {
                    const f32x4 b0 = ldb4(binp, 256 * pn + 128 * bj + c8), b1 = ldb4(binp, 256 * pn + 128 * bj + c8 + 4);
#pragma unroll
                    for (int ai = 0; ai < 2; ++ai)
#pragma unroll
                        for (int m = 0; m < 4; ++m) {
                            const int row = rowb + ai * 128 + m * 16;
                            f32x4 r[2];
#pragma unroll
                            for (int n = 0; n < 2; ++n)
#pragma unroll
                                for (int j = 0; j < 4; ++j) {
                                    const float v = acc[ai][bj][m][n][j] + (n ? b1[j] : b0[j]);
                                    const float arg = act == 0 ? 1.5957691216057308f * (v + 0.044715f * v * v * v) : v;
                                    const float s = sigm(arg);
                                    r[n][j] = act == 1 ? v : (act == 3 ? s : v * s);
                                }
                            *(h8*)(dst + (size_t)row * ldd + colt + 128 * bj + c8) = pack8(r[0], r[1]);
                        }
                }
            }
        } else if (kind == EK_MRG) {
            const half_t* gate = (const half_t*)GP(P->out) + (size_t)T * DM;
            half_t* merged = (half_t*)(ws + OFF_S5);
#pragma unroll
            for (int ai = 0; ai < 2; ++ai) {
                h8 gv[4][2];
#pragma unroll
                for (int m = 0; m < 4; ++m)
#pragma unroll
                    for (int bj = 0; bj < 2; ++bj) gv[m][bj] = *(const h8*)(gate + (size_t)(rowb + ai * 128 + m * 16) * DM + u.pn * 256 + 128 * bj + c8);
                asm volatile("" ::: "memory");
#pragma unroll
                for (int m = 0; m < 4; ++m)
#pragma unroll
                    for (int bj = 0; bj < 2; ++bj) {
                        const size_t o = (size_t)(rowb + ai * 128 + m * 16) * DM + u.pn * 256 + 128 * bj + c8;
                        f32x4 r0, r1;
#pragma unroll
                        for (int j = 0; j < 4; ++j) { r0[j] = (float)gv[m][bj][j] * acc[ai][bj][m][0][j]; r1[j] = (float)gv[m][bj][4 + j] * acc[ai][bj][m][1][j]; }
                        *(h8*)(merged + o) = pack8(r0, r1);
                    }
                asm volatile("" ::: "memory");
            }
        } else if (kind == EK_WO) {
            half_t* z1 = (half_t*)(ws + OFF_S3);
            const float* st0 = (const float*)(ws + OFF_ST0);
            f32x4 g0[2], g1[2], b0[2], b1[2];
#pragma unroll
            for (int bj = 0; bj < 2; ++bj) { const int col = u.pn * 256 + 128 * bj + c8;
                g0[bj] = *(const f32x4*)(GP(P->ln0_g) + col); g1[bj] = *(const f32x4*)(GP(P->ln0_g) + col + 4); b0[bj] = *(const f32x4*)(GP(P->ln0_b) + col); b1[bj] = *(const f32x4*)(GP(P->ln0_b) + col + 4); }
#pragma unroll
            for (int ai = 0; ai < 2; ++ai)
#pragma unroll
                for (int mh = 0; mh < 2; ++mh) {
                    f32x2 ms[2]; f32x4 x0[2][2], x1[2][2];
#pragma unroll
                    for (int mm = 0; mm < 2; ++mm) { const int row = rowb + ai * 128 + (2 * mh + mm) * 16;
                        ms[mm] = *(const f32x2*)(st0 + 2 * row);
#pragma unroll
                        for (int bj = 0; bj < 2; ++bj) { const size_t o = (size_t)row * DM + u.pn * 256 + 128 * bj + c8; x0[mm][bj] = __builtin_nontemporal_load((const f32x4*)(GP(P->x) + o)); x1[mm][bj] = __builtin_nontemporal_load((const f32x4*)(GP(P->x) + o + 4)); } }
                    asm volatile("" ::: "memory");
#pragma unroll
                    for (int mm = 0; mm < 2; ++mm)
#pragma unroll
                        for (int bj = 0; bj < 2; ++bj) { const int m = 2 * mh + mm; const size_t o = (size_t)(rowb + ai * 128 + m * 16) * DM + u.pn * 256 + 128 * bj + c8;
                            f32x4 r0, r1;
#pragma unroll
                            for (int j = 0; j < 4; ++j) {
                                r0[j] = ALPHA * ((x0[mm][bj][j] - ms[mm][0]) * ms[mm][1] * g0[bj][j] + b0[bj][j]) + acc[ai][bj][m][0][j];
                                r1[j] = ALPHA * ((x1[mm][bj][j] - ms[mm][0]) * ms[mm][1] * g1[bj][j] + b1[bj][j]) + acc[ai][bj][m][1][j];
                            }
                            *(h8*)(z1 + o) = pack8(r0, r1); }
                    asm volatile("" ::: "memory");
                }
        } else if (kind == EK_FFN) {
            if (u.pn < 22) {
                half_t* hid = (half_t*)(ws + OFF_S5);
#pragma unroll
                for (int ai = 0; ai < 2; ++ai)
#pragma unroll
                    for (int m = 0; m < 4; ++m) {
                        const int row = rowb + ai * 128 + m * 16;
                        f32x4 r[2];
#pragma unroll
                        for (int n = 0; n < 2; ++n)
#pragma unroll
                            for (int j = 0; j < 4; ++j) { const float gt = acc[ai][0][m][n][j]; r[n][j] = gt * sigm(gt) * acc[ai][1][m][n][j]; }
                        *(h8*)(hid + (size_t)row * HPW + PLE + 128 * u.pn + c8) = pack8(r[0], r[1]);
                    }
            } else {
                half_t* pg = (half_t*)(ws + OFF_S2);
#pragma unroll
                for (int bj = 0; bj < 2; ++bj) {
                    const int col = (u.pn - 22) * 256 + 128 * bj + c8;
                    const f32x4 b0 = *(const f32x4*)(GP(P->bpg) + col), b1 = *(const f32x4*)(GP(P->bpg) + col + 4);
#pragma unroll
                    for (int ai = 0; ai < 2; ++ai)
#pragma unroll
                        for (int m = 0; m < 4; ++m) {
                            const int row = rowb + ai * 128 + m * 16;
                            f32x4 r[2];
#pragma unroll
                            for (int n = 0; n < 2; ++n)
#pragma unroll
                                for (int j = 0; j < 4; ++j) r[n][j] = sigm(acc[ai][bj][m][n][j] + (n ? b1[j] : b0[j]));
                            *(h8*)(pg + (size_t)row * DM + col) = pack8(r[0], r[1]);
                        }
                }
            }
        } else if (kind == EK_DOWN) {
            const half_t* h1 = (const half_t*)(ws + OFF_S1);
            half_t* z2 = (half_t*)(ws + OFF_S3);
#pragma unroll
            for (int ai = 0; ai < 2; ++ai) {
                h8 hv[4][2];
#pragma unroll
                for (int m = 0; m < 4; ++m)
#pragma unroll
                    for (int bj = 0; bj < 2; ++bj) hv[m][bj] = *(const h8*)(h1 + (size_t)(rowb + ai * 128 + m * 16) * DM + u.pn * 256 + 128 * bj + c8);
                asm volatile("" ::: "memory");
#pragma unroll
                for (int m = 0; m < 4; ++m)
#pragma unroll
                    for (int bj = 0; bj < 2; ++bj) {
                        const size_t o = (size_t)(rowb + ai * 128 + m * 16) * DM + u.pn * 256 + 128 * bj + c8;
                        f32x4 r0, r1;
#pragma unroll
                        for (int j = 0; j < 4; ++j) { r0[j] = acc[ai][bj][m][0][j] + ALPHA * (float)hv[m][bj][j]; r1[j] = acc[ai][bj][m][1][j] + ALPHA * (float)hv[m][bj][4 + j]; }
                        *(h8*)(z2 + o) = pack8(r0, r1);
                    }
                asm volatile("" ::: "memory");
            }
        }
    }
};

__device__ __forceinline__ void transpose_job(const float* src, int ld, int col0, half_t* dst, int dld, int dk0, int r0, int k0, float* tile, bool bf = false) {
    const int tid = otid();
    f32x4 tv[4];
#pragma unroll
    for (int i = 0; i < 4; ++i) { const int idx = tid + 512 * i, k = idx >> 4, n4 = idx & 15; tv[i] = __builtin_nontemporal_load((const f32x4*)(src + (size_t)(k0 + k) * ld + col0 + 4 * n4)); }
    asm volatile("" ::: "memory");
#pragma unroll
    for (int i = 0; i < 4; ++i) { const int idx = tid + 512 * i, k = idx >> 4, n4 = idx & 15; *(f32x4*)(tile + k * 68 + 4 * n4) = tv[i]; }
    __syncthreads();
#pragma unroll
    for (int i = 0; i < 2; ++i) { const int idx = tid + 512 * i, n = idx & 63, k8 = idx >> 6; h8 v; s8v vb;
#pragma unroll
        for (int j = 0; j < 8; ++j) { const float t = tile[(8 * k8 + j) * 68 + n]; v[j] = (half_t)t; vb[j] = (short)f2bf(t); }
        if (bf) *(s8v*)(dst + (size_t)(r0 + n) * dld + dk0 + k0 + 8 * k8) = vb; else *(h8*)(dst + (size_t)(r0 + n) * dld + dk0 + k0 + 8 * k8) = v; }
    __syncthreads();
}
__device__ __forceinline__ void ln_row(const float* xr, const float* g, const float* b, half_t* o16, float* o32, float* stat, int lane) {
    f32x4 v[4]; float s = 0.f;
#pragma unroll
    for (int j = 0; j < 4; ++j) { v[j] = *(const f32x4*)(xr + 4 * lane + 256 * j); s += (v[j][0] + v[j][1]) + (v[j][2] + v[j][3]); }
    const float mean = wave_sum(s) * (1.f / DM); float s2 = 0.f;
#pragma unroll
    for (int j = 0; j < 4; ++j) { v[j] = v[j] - mean; s2 += (v[j][0] * v[j][0] + v[j][1] * v[j][1]) + (v[j][2] * v[j][2] + v[j][3] * v[j][3]); }
    const float rstd = 1.f / sqrtf(wave_sum(s2) * (1.f / DM) + 1e-5f);
    if (stat && lane == 0) { stat[0] = mean; stat[1] = rstd; }
#pragma unroll
    for (int j = 0; j < 4; ++j) {
        const f32x4 gg = *(const f32x4*)(g + 4 * lane + 256 * j), bb = *(const f32x4*)(b + 4 * lane + 256 * j);
        const f32x4 y = v[j] * rstd * gg + bb;
        if (o16) { h4 hv; hv[0] = (half_t)y[0]; hv[1] = (half_t)y[1]; hv[2] = (half_t)y[2]; hv[3] = (half_t)y[3]; *(h4*)(o16 + 4 * lane + 256 * j) = hv; }
        if (o32) *(f32x4*)(o32 + 4 * lane + 256 * j) = y;
    }
}
__device__ __forceinline__ void ln_row16(const half_t* xr, const float* g, const float* b, half_t* o16, float* o32, int lane, unsigned short* ob16 = nullptr) {
    const h8 a = *(const h8*)(xr + 8 * lane), c = *(const h8*)(xr + 512 + 8 * lane);
    float v[16]; float s = 0.f;
#pragma unroll
    for (int i = 0; i < 8; ++i) { v[i] = (float)a[i]; v[8 + i] = (float)c[i]; s += v[i] + v[8 + i]; }
    const float mean = wave_sum(s) * (1.f / DM); float s2 = 0.f;
#pragma unroll
    for (int i = 0; i < 16; ++i) { v[i] -= mean; s2 += v[i] * v[i]; }
    const float rstd = 1.f / sqrtf(wave_sum(s2) * (1.f / DM) + 1e-5f);
#pragma unroll
    for (int hf = 0; hf < 2; ++hf) {
        const int col = 512 * hf + 8 * lane;
        const f32x4 g0 = *(const f32x4*)(g + col), g1 = *(const f32x4*)(g + col + 4), b0 = *(const f32x4*)(b + col), b1 = *(const f32x4*)(b + col + 4);
        f32x4 y0, y1;
#pragma unroll
        for (int j = 0; j < 4; ++j) { y0[j] = v[8 * hf + j] * rstd * g0[j] + b0[j]; y1[j] = v[8 * hf + 4 + j] * rstd * g1[j] + b1[j]; }
        if (o16) *(h8*)(o16 + col) = pack8(y0, y1);
        if (ob16) *(s8v*)(ob16 + col) = pack8b(y0, y1);
        if (o32) { *(f32x4*)(o32 + col) = y0; *(f32x4*)(o32 + col + 4) = y1; }
    }
}
__device__ __forceinline__ void phase_prep(KP P, unsigned char* lds) {
    unsigned char* ws = sopq(GP(P->ws));
    float* tile = (float*)lds;
    const int G = gridDim.x;
    constexpr int J_WIN = 1024, J_SQ = 128, J_GU = 832, J_WD = 352, J_PLE = 32, J_ALL = J_WIN + 3 * J_SQ + J_GU + J_WD + J_PLE;
    for (int j = blockIdx.x; j < J_ALL; j += G) {
        int r = j;
        if (r < J_WIN) { const int rt = r >> 3, kt = r & 7; transpose_job(GP(P->w_in), DIN, map_win(rt * 64), (half_t*)(ws + OFF_WIN), DM, 0, rt * 64, kt * 128, tile, BF_P1); continue; } r -= J_WIN;
        if (r < 3 * J_SQ) { const int w = r >> 7, rr = r & 127, rt = rr >> 3, kt = rr & 7;
            if (w < 2) transpose_job(w == 0 ? GP(P->w_a) : GP(P->w_b), DM, rt * 64, (half_t*)(ws + OFF_WA), YAB, w * DM, rt * 64, kt * 128, tile);
            else transpose_job(GP(P->w_o), DM, rt * 64, (half_t*)(ws + OFF_WO), DM, 0, rt * 64, kt * 128, tile);
            continue; } r -= 3 * J_SQ;
        if (r < J_GU) { const int rt = r >> 3, kt = r & 7, r0 = rt * 64; const float* src; int ld, col;
            if (r0 < 5632) { const int un = r0 >> 8, rho = r0 & 255; ld = DFF; if (rho < 128) { src = GP(P->wg); col = 128 * un + rho; } else { src = GP(P->wu); col = 128 * un + rho - 128; } }
            else { src = GP(P->wpg); ld = DM; col = r0 - 5632; }
            transpose_job(src, ld, col, (half_t*)(ws + OFF_WGU), DM, 0, r0, kt * 128, tile, BF_P9); continue; } r -= J_GU;
        if (r < J_WD) { const int rt = r / 22, kt = r % 22; transpose_job(GP(P->wd), DM, rt * 64, (half_t*)(ws + OFF_WD), HPW, PLE, rt * 64, kt * 128, tile); continue; } r -= J_WD;
        { const int rt = r >> 1, kt = r & 1; transpose_job(GP(P->wple), DM, rt * 64, (half_t*)(ws + OFF_WD), HPW, 0, rt * 64, kt * 128, tile); }
    }
    const int tidp = otid(); const int gt = blockIdx.x * 512 + tidp;
    if (gt < DIN) ((float*)(ws + OFF_BINP))[gt] = GP(P->b_in)[map_win(gt)];
    if (gt < DM) ((float*)(ws + OFF_LB))[gt] = sigm(GP(P->lbl)[gt] - GP(P->lbl)[DM + gt]);
    const int lane = tidp & 63, gw = blockIdx.x * 8 + (tidp >> 6);
    for (int row = gw; row < T; row += 2 * G * 8) {
        const int row2 = row + G * 8;
        const float* x0 = GP(P->x) + (size_t)row * DM; const float* x1 = GP(P->x) + (size_t)(row2 < T ? row2 : row) * DM;
        f32x4 va[4], vb[4]; float sa = 0.f, sb = 0.f;
#pragma unroll
        for (int j = 0; j < 4; ++j) { va[j] = __builtin_nontemporal_load((const f32x4*)(x0 + 4 * lane + 256 * j)); vb[j] = __builtin_nontemporal_load((const f32x4*)(x1 + 4 * lane + 256 * j)); }
#pragma unroll
        for (int j = 0; j < 4; ++j) { sa += (va[j][0] + va[j][1]) + (va[j][2] + va[j][3]); sb += (vb[j][0] + vb[j][1]) + (vb[j][2] + vb[j][3]); }
        const float ma = wave_sum(sa) * (1.f / DM), mb = wave_sum(sb) * (1.f / DM); float qa = 0.f, qb = 0.f;
#pragma unroll
        for (int j = 0; j < 4; ++j) { va[j] = va[j] - ma; vb[j] = vb[j] - mb;
            qa += (va[j][0] * va[j][0] + va[j][1] * va[j][1]) + (va[j][2] * va[j][2] + va[j][3] * va[j][3]);
            qb += (vb[j][0] * vb[j][0] + vb[j][1] * vb[j][1]) + (vb[j][2] * vb[j][2] + vb[j][3] * vb[j][3]); }
        const float ra = 1.f / sqrtf(wave_sum(qa) * (1.f / DM) + 1e-5f), rb = 1.f / sqrtf(wave_sum(qb) * (1.f / DM) + 1e-5f);
        float* st = (float*)(ws + OFF_ST0);
        if (lane == 0) { st[2 * row] = ma; st[2 * row + 1] = ra; if (row2 < T) { st[2 * row2] = mb; st[2 * row2 + 1] = rb; } }
        half_t* o0 = (half_t*)(ws + OFF_S1) + (size_t)row * DM; half_t* o1 = (half_t*)(ws + OFF_S1) + (size_t)row2 * DM;
#pragma unroll
        for (int j = 0; j < 4; ++j) {
            const f32x4 gg = *(const f32x4*)(GP(P->ln0_g) + 4 * lane + 256 * j), bb = *(const f32x4*)(GP(P->ln0_b) + 4 * lane + 256 * j);
            const f32x4 ya = va[j] * ra * gg + bb, yb = vb[j] * rb * gg + bb;
            h4 ha, hb;
#pragma unroll
            for (int k = 0; k < 4; ++k) {
                if (BF_P1) { ha[k] = __builtin_bit_cast(half_t, f2bf(ya[k])); hb[k] = __builtin_bit_cast(half_t, f2bf(yb[k])); }
                else { ha[k] = (half_t)ya[k]; hb[k] = (half_t)yb[k]; }
            }
            *(h4*)(o0 + 4 * lane + 256 * j) = ha;
            if (row2 < T) *(h4*)(o1 + 4 * lane + 256 * j) = hb;
        }
    }
}

__device__ __forceinline__ void gmlp_item(KP P, unsigned char* lds, int item, bool dry = false) {
    unsigned char* ws = sopq(GP(P->ws));
    const int tid = otid(), lane = tid & 63, w = tid >> 6, l15 = lane & 15, quad = lane >> 4;
    const int tok0 = item * 128;
    half_t* U = (half_t*)(ws + OFF_S2); const half_t* V = (const half_t*)(ws + OFF_S7);
    half_t* Ws = (half_t*)lds; half_t* vnT = (half_t*)(lds + 34816); float* mean = (float*)(lds + 69632); float* rstd = mean + 128;
    for (int r4 = 0; r4 < 16; r4 += 4) {
        h8 a[4], b[4];
#pragma unroll
        for (int r = 0; r < 4; ++r) { const half_t* vr = V + (size_t)(tok0 + 16 * w + r4 + r) * DM; a[r] = *(const h8*)(vr + lane * 8); b[r] = *(const h8*)(vr + 512 + lane * 8); }
        asm volatile("" ::: "memory");
#pragma unroll
        for (int r = 0; r < 4; ++r) {
            const int t = 16 * w + r4 + r;
            float s = 0.f, s2 = 0.f;
#pragma unroll
            for (int i = 0; i < 8; ++i) { const float x0 = (float)a[r][i], x1 = (float)b[r][i]; s += x0 + x1; s2 += x0 * x0 + x1 * x1; }
            s = wave_sum(s); s2 = wave_sum(s2);
            const float mu = s * (1.f / DM), var = fmaxf(s2 * (1.f / DM) - mu * mu, 0.f);
            if (lane == 0) { mean[t] = mu; rstd[t] = 1.f / sqrtf(var + 1e-5f); }
        }
    }
    __syncthreads();
    for (int g = 0; g < 8; ++g) {
        f32x4 wvv[8];
#pragma unroll
        for (int i = 0; i < 8; ++i) { const int idx = tid + 512 * i, t = idx >> 5, s4 = idx & 31; wvv[i] = *(const f32x4*)(GP(P->gm_ws) + ((size_t)(g * 128 + t)) * 128 + 4 * s4); }
        h8 vvv[4];
#pragma unroll
        for (int i = 0; i < 4; ++i) { const int idx = i * 8 + w, cc8 = idx & 15, s = (idx >> 4) * 64 + lane; vvv[i] = *(const h8*)(V + (size_t)(tok0 + s) * DM + g * 128 + 8 * cc8); }
        asm volatile("" ::: "memory");
#pragma unroll
        for (int i = 0; i < 8; ++i) {
            const int idx = tid + 512 * i, t = idx >> 5, s4 = idx & 31;
            f32x4 wv = wvv[i];
            if ((t >> 6) < ((4 * s4) >> 6)) wv = (f32x4){0.f, 0.f, 0.f, 0.f};
            h4 hv; hv[0] = (half_t)wv[0]; hv[1] = (half_t)wv[1]; hv[2] = (half_t)wv[2]; hv[3] = (half_t)wv[3];
            *(h4*)(Ws + t * 136 + 4 * s4) = hv;
        }
#pragma unroll
        for (int i = 0; i < 4; ++i) {
            const int idx = i * 8 + w, cc8 = idx & 15, s = (idx >> 4) * 64 + lane;
            const h8 v = vvv[i];
            const float mu = mean[s], rs = rstd[s];
            const f32x4 ga = *(const f32x4*)(GP(P->gm_g) + g * 128 + 8 * cc8), gb = *(const f32x4*)(GP(P->gm_g) + g * 128 + 8 * cc8 + 4);
            const f32x4 ba = *(const f32x4*)(GP(P->gm_b) + g * 128 + 8 * cc8), bb = *(const f32x4*)(GP(P->gm_b) + g * 128 + 8 * cc8 + 4);
#pragma unroll
            for (int k = 0; k < 8; ++k) {
                const float gg = k < 4 ? ga[k & 3] : gb[k & 3], bt = k < 4 ? ba[k & 3] : bb[k & 3];
                vnT[(8 * cc8 + k) * 136 + s] = (half_t)(((float)v[k] - mu) * rs * gg + bt);
            }
        }
        __syncthreads();
        const int nks = w < 4 ? 2 : 4;
        h8 Bf[4];
#pragma unroll
        for (int ks = 0; ks < 4; ++ks) Bf[ks] = *(const h8*)(Ws + (16 * w + l15) * 136 + 32 * ks + 8 * quad);
        const int t = 16 * w + l15;
        const float bias = GP(P->gm_bs)[g * 128 + t];
        h4 uvv[8];
#pragma unroll
        for (int ct = 0; ct < 8; ++ct) uvv[ct] = *(const h4*)(U + (size_t)(tok0 + t) * YAB + g * 128 + 16 * ct + 4 * quad);
#pragma unroll
        for (int ct = 0; ct < 8; ++ct) {
            f32x4 acc = (f32x4){0.f, 0.f, 0.f, 0.f};
#pragma unroll
            for (int ks = 0; ks < 4; ++ks) if (ks < nks) {
                const h8 Af = *(const h8*)(vnT + (16 * ct + l15) * 136 + 32 * ks + 8 * quad);
                acc = __builtin_amdgcn_mfma_f32_16x16x32_f16(Af, Bf[ks], acc, 0, 0, 0);
            }
            half_t* up = U + (size_t)(tok0 + t) * YAB + g * 128 + 16 * ct + 4 * quad;
            const h4 uv = uvv[ct]; h4 y;
#pragma unroll
            for (int j = 0; j < 4; ++j) y[j] = (half_t)((float)uv[j] * (acc[j] + bias));
            if (!dry) *(h4*)up = y;
        }
        __syncthreads();
    }
}

constexpr int HB_QD = 0, HB_QDB = 4352, HB_KDEC = 8704, HB_KET = 13056, HB_VT = 18176, HB_DEC = 23296, HB_OB = 23808, HB_SIZE = 32256;
constexpr int SEGL = 512, NSEG = 16, NCH = 32, NITEM = 32 * NSEG;

template <bool EMIT>
__device__ __forceinline__ void hgrn_item(KP P, unsigned char* lds, int item, bool dry = false) {
    unsigned char* ws = sopq(GP(P->ws));
    const int tid = otid(), lane = tid & 63, w = tid >> 6, l15 = lane & 15, quad = lane >> 4;
    const int bh = item / NSEG, seg = item % NSEG, b = bh >> 3, h = bh & 7;
    const int tokbase = b * 8192 + seg * SEGL, colbase = h * 128;
    const half_t* Q = (const half_t*)(ws + OFF_S4); const half_t* F = (const half_t*)(ws + OFF_S5); const half_t* I = (const half_t*)(ws + OFF_S6);
    half_t* Gp = (half_t*)(ws + OFF_S2) + DM;
    const float* decay = (const float*)(ws + OFF_DECAY);
    float* Sbuf = (float*)(ws + OFF_S1) + (size_t)item * 16384;
    const int half = tid >> 8, pp = tid & 255, st = pp & 15, sc8 = pp >> 4;
    f32x4 S[8];
#pragma unroll
    for (int dt = 0; dt < 8; ++dt) {
        if (EMIT) {
#pragma unroll
            for (int r = 0; r < 4; ++r) S[dt][r] = Sbuf[((w * 8 + dt) * 4 + r) * 64 + lane];
        } else S[dt] = (f32x4){0.f, 0.f, 0.f, 0.f};
    }
    float dprod = 1.f;
    h8 r0, r1; f32x4 rd0, rd1; h2 gcur[2], gprev[2];
    { const float one = __int_as_float(vopq(0x3f800000)); rd0 = rd1 = (f32x4){one, one, one, one}; const half_t hz = (half_t)__int_as_float(vopq(0)); r1 = r0 = (h8)hz; }
    { const half_t hz = (half_t)__int_as_float(vopq(0)); gcur[0] = gcur[1] = gprev[0] = gprev[1] = (h2)hz; }
    const float og0 = GP(P->hg_g)[colbase + 2 * lane], og1 = GP(P->hg_g)[colbase + 2 * lane + 1];
    {
        const size_t o = (size_t)(tokbase + st) * DM + colbase + 8 * sc8;
        if (half == 0) { r0 = __builtin_nontemporal_load((const h8*)(Q + o)); r1 = __builtin_nontemporal_load((const h8*)(F + o)); const float* dp = decay + (size_t)(tokbase >> 4) * DM + colbase + 8 * sc8; rd0 = __builtin_nontemporal_load((const f32x4*)dp); rd1 = __builtin_nontemporal_load((const f32x4*)(dp + 4)); }
        else r0 = __builtin_nontemporal_load((const h8*)(I + o));
    }
#pragma unroll 1
    for (int c = 0; c < NCH; ++c) {
        unsigned char* base = lds + (c & 1) * HB_SIZE;
        if (half == 0) {
            *(h8*)(base + HB_QD + (st * 136 + 8 * sc8) * 2) = r0;
            s8v qb, kb;
#pragma unroll
            for (int i = 0; i < 8; ++i) {
                qb[i] = (short)f2bf((float)r0[i]);
                const float dv = i < 4 ? rd0[i & 3] : rd1[i & 3];
                kb[i] = (short)f2bf((float)r1[i] * __builtin_amdgcn_rcpf(dv));
                *(half_t*)(base + HB_KET + ((8 * sc8 + i) * 20 + st) * 2) = r1[i];
            }
            *(s8v*)(base + HB_QDB + (st * 136 + 8 * sc8) * 2) = qb;
            *(s8v*)(base + HB_KDEC + (st * 136 + 8 * sc8) * 2) = kb;
            if (st == 0) { float* dq = (float*)(base + HB_DEC) + 8 * sc8; *(f32x4*)dq = rd0; *(f32x4*)(dq + 4) = rd1; }
        } else {
#pragma unroll
            for (int i = 0; i < 8; ++i) *(half_t*)(base + HB_VT + ((8 * sc8 + i) * 20 + st) * 2) = r0[i];
        }
        if (EMIT) {
            gprev[0] = gcur[0]; gprev[1] = gcur[1];
#pragma unroll
            for (int tt = 0; tt < 2; ++tt) gcur[tt] = *(const h2*)(Gp + (size_t)(tokbase + c * 16 + 2 * w + tt) * YAB + colbase + 2 * lane);
        }
        if (c + 1 < NCH) {
            const size_t o = (size_t)(tokbase + (c + 1) * 16 + st) * DM + colbase + 8 * sc8;
            if (half == 0) { r0 = __builtin_nontemporal_load((const h8*)(Q + o)); r1 = __builtin_nontemporal_load((const h8*)(F + o)); const float* dp = decay + (size_t)((tokbase >> 4) + c + 1) * DM + colbase + 8 * sc8; rd0 = __builtin_nontemporal_load((const f32x4*)dp); rd1 = __builtin_nontemporal_load((const f32x4*)(dp + 4)); }
            else r0 = __builtin_nontemporal_load((const h8*)(I + o));
        }
        __syncthreads();
        if (!EMIT) { if (tid < 128) dprod *= ((const float*)(base + HB_DEC))[tid]; }
        if (EMIT && c >= 1) {
            const float* ob = (const float*)(lds + ((c - 1) & 1) * HB_SIZE + HB_OB);
#pragma unroll
            for (int tt = 0; tt < 2; ++tt) {
                const int t = 2 * w + tt;
                const f32x2 v = *(const f32x2*)(ob + t * 132 + 2 * lane);
                const float ss = wave_sum(v[0] * v[0] + v[1] * v[1]);
                const float rr = 1.f / sqrtf(ss * (1.f / 128.f) + 1e-6f);
                const float g0 = (float)gprev[tt][0], g1 = (float)gprev[tt][1];
                h2 y; y[0] = (half_t)(v[0] * rr * og0 * g0); y[1] = (half_t)(v[1] * rr * og1 * g1);
                if (!dry) *(h2*)(Gp + (size_t)(tokbase + (c - 1) * 16 + t) * YAB + colbase + 2 * lane) = y;
            }
        }
        const h4 vB = *(const h4*)(base + HB_VT + ((16 * w + l15) * 20 + 4 * quad) * 2);
        if (EMIT) {
            f32x4 sc = (f32x4){0.f, 0.f, 0.f, 0.f};
#pragma unroll
            for (int ks = 0; ks < 4; ++ks) {
                const s8v ka = *(const s8v*)(base + HB_KDEC + (l15 * 136 + 32 * ks + 8 * quad) * 2);
                const s8v qb = *(const s8v*)(base + HB_QDB + (l15 * 136 + 32 * ks + 8 * quad) * 2);
                sc = __builtin_amdgcn_mfma_f32_16x16x32_bf16(__builtin_bit_cast(__attribute__((ext_vector_type(8))) __bf16, ka), __builtin_bit_cast(__attribute__((ext_vector_type(8))) __bf16, qb), sc, 0, 0, 0);
            }
            h4 scA;
#pragma unroll
            for (int r = 0; r < 4; ++r) scA[r] = (half_t)((4 * quad + r) <= l15 ? sc[r] : 0.f);
            f32x4 o = __builtin_amdgcn_mfma_f32_16x16x16f16(scA, vB, (f32x4){0.f, 0.f, 0.f, 0.f}, 0, 0, 0); MFMA16_KEEP(scA, vB);
#pragma unroll
            for (int ks = 0; ks < 4; ++ks) {
                const h4 qa = *(const h4*)(base + HB_QD + (l15 * 136 + 32 * ks + 4 * quad) * 2);
                const h4 qc = *(const h4*)(base + HB_QD + (l15 * 136 + 32 * ks + 16 + 4 * quad) * 2);
                h8 qA, sB;
#pragma unroll
                for (int j = 0; j < 4; ++j) { qA[j] = qa[j]; qA[4 + j] = qc[j]; sB[j] = (half_t)S[2 * ks][j]; sB[4 + j] = (half_t)S[2 * ks + 1][j]; }
                o = __builtin_amdgcn_mfma_f32_16x16x32_f16(qA, sB, o, 0, 0, 0);
            }
            float* ob = (float*)(base + HB_OB);
#pragma unroll
            for (int r = 0; r < 4; ++r) ob[(4 * quad + r) * 132 + 16 * w + l15] = o[r];
        }
#pragma unroll
        for (int dt = 0; dt < 8; ++dt) {
            const f32x4 dv = *(const f32x4*)(base + HB_DEC + (16 * dt + 4 * quad) * 4);
            const h4 kA = *(const h4*)(base + HB_KET + ((16 * dt + l15) * 20 + 4 * quad) * 2);
            S[dt] = __builtin_amdgcn_mfma_f32_16x16x16f16(kA, vB, S[dt] * dv, 0, 0, 0); MFMA16_KEEP(kA, vB);
        }
    }
    if (EMIT) {
        __syncthreads();
        const float* ob = (const float*)(lds + ((NCH - 1) & 1) * HB_SIZE + HB_OB);
#pragma unroll
        for (int tt = 0; tt < 2; ++tt) {
            const int t = 2 * w + tt;
            const f32x2 v = *(const f32x2*)(ob + t * 132 + 2 * lane);
            const float ss = wave_sum(v[0] * v[0] + v[1] * v[1]);
            const float rr = 1.f / sqrtf(ss * (1.f / 128.f) + 1e-6f);
            const float g0 = (float)gcur[tt][0], g1 = (float)gcur[tt][1];
            h2 y; y[0] = (half_t)(v[0] * rr * og0 * g0); y[1] = (half_t)(v[1] * rr * og1 * g1);
            if (!dry) *(h2*)(Gp + (size_t)(tokbase + (NCH - 1) * 16 + t) * YAB + colbase + 2 * lane) = y;
        }
    } else {
#pragma unroll
        for (int dt = 0; dt < 8; ++dt)
#pragma unroll
            for (int r = 0; r < 4; ++r) if (!dry) Sbuf[((w * 8 + dt) * 4 + r) * 64 + lane] = S[dt][r];
        if (tid < 128 && !dry) ((float*)(ws + OFF_DSEG))[(size_t)item * 128 + tid] = dprod;
    }
    __syncthreads();
}


__device__ __forceinline__ void hgrn_pairA(KP P, unsigned char* lds, int item0, int item1) {
    unsigned char* ws = sopq(GP(P->ws));
    const int tid = otid(), lane = tid & 63, w = tid >> 6, l15 = lane & 15, quad = lane >> 4;
    const half_t* F = (const half_t*)(ws + OFF_S5); const half_t* I = (const half_t*)(ws + OFF_S6);
    const float* decay = (const float*)(ws + OFF_DECAY);
    const int half = tid >> 8, pp = tid & 255, st = pp & 15, sc8 = pp >> 4;
    int tokbase[2], colbase[2];
#pragma unroll
    for (int j = 0; j < 2; ++j) { const int item = j ? item1 : item0, bh = item / NSEG, seg = item % NSEG; tokbase[j] = (bh >> 3) * 8192 + seg * SEGL; colbase[j] = (bh & 7) * 128; }
    f32x4 S[2][8];
#pragma unroll
    for (int j = 0; j < 2; ++j)
#pragma unroll
        for (int dt = 0; dt < 8; ++dt) S[j][dt] = (f32x4){0.f, 0.f, 0.f, 0.f};
    float dprod[2] = {1.f, 1.f};
    h8 r[2]; f32x4 rd0[2], rd1[2];
    { const float one = __int_as_float(vopq(0x3f800000)); const half_t hz = (half_t)__int_as_float(vopq(0));
#pragma unroll
      for (int j = 0; j < 2; ++j) { rd0[j] = rd1[j] = (f32x4){one, one, one, one}; r[j] = (h8)hz; } }
#pragma unroll
    for (int j = 0; j < 2; ++j) {
        const size_t o = (size_t)(tokbase[j] + st) * DM + colbase[j] + 8 * sc8;
        if (half == 0) { r[j] = __builtin_nontemporal_load((const h8*)(F + o)); const float* dp = decay + (size_t)(tokbase[j] >> 4) * DM + colbase[j] + 8 * sc8; rd0[j] = __builtin_nontemporal_load((const f32x4*)dp); rd1[j] = __builtin_nontemporal_load((const f32x4*)(dp + 4)); }
        else r[j] = __builtin_nontemporal_load((const h8*)(I + o));
    }
#pragma unroll 1
    for (int c = 0; c < NCH; ++c) {
#pragma unroll
        for (int j = 0; j < 2; ++j) {
            unsigned char* base = lds + (2 * j + (c & 1)) * HB_SIZE;
            if (half == 0) {
#pragma unroll
                for (int i = 0; i < 8; ++i) *(half_t*)(base + HB_KET + ((8 * sc8 + i) * 20 + st) * 2) = r[j][i];
                if (st == 0) { float* dq = (float*)(base + HB_DEC) + 8 * sc8; *(f32x4*)dq = rd0[j]; *(f32x4*)(dq + 4) = rd1[j]; }
            } else {
#pragma unroll
                for (int i = 0; i < 8; ++i) *(half_t*)(base + HB_VT + ((8 * sc8 + i) * 20 + st) * 2) = r[j][i];
            }
        }
        if (c + 1 < NCH) {
#pragma unroll
            for (int j = 0; j < 2; ++j) {
                const size_t o = (size_t)(tokbase[j] + (c + 1) * 16 + st) * DM + colbase[j] + 8 * sc8;
                if (half == 0) { r[j] = __builtin_nontemporal_load((const h8*)(F + o)); const float* dp = decay + (size_t)((tokbase[j] >> 4) + c + 1) * DM + colbase[j] + 8 * sc8; rd0[j] = __builtin_nontemporal_load((const f32x4*)dp); rd1[j] = __builtin_nontemporal_load((const f32x4*)(dp + 4)); }
                else r[j] = __builtin_nontemporal_load((const h8*)(I + o));
            }
        }
        __syncthreads();
#pragma unroll
        for (int j = 0; j < 2; ++j) {
            unsigned char* base = lds + (2 * j + (c & 1)) * HB_SIZE;
            if (tid < 128) dprod[j] *= ((const float*)(base + HB_DEC))[tid];
            const h4 vB = *(const h4*)(base + HB_VT + ((16 * w + l15) * 20 + 4 * quad) * 2);
#pragma unroll
            for (int dt = 0; dt < 8; ++dt) {
                const f32x4 dv = *(const f32x4*)(base + HB_DEC + (16 * dt + 4 * quad) * 4);
                const h4 kA = *(const h4*)(base + HB_KET + ((16 * dt + l15) * 20 + 4 * quad) * 2);
                S[j][dt] = __builtin_amdgcn_mfma_f32_16x16x16f16(kA, vB, S[j][dt] * dv, 0, 0, 0); MFMA16_KEEP(kA, vB);
            }
        }
    }
#pragma unroll
    for (int j = 0; j < 2; ++j) {
        const int item = j ? item1 : item0;
        float* Sbuf = (float*)(ws + OFF_S1) + (size_t)item * 16384;
#pragma unroll
        for (int dt = 0; dt < 8; ++dt)
#pragma unroll
            for (int rr = 0; rr < 4; ++rr) Sbuf[((w * 8 + dt) * 4 + rr) * 64 + lane] = S[j][dt][rr];
        if (tid < 128) ((float*)(ws + OFF_DSEG))[(size_t)item * 128 + tid] = dprod[j];
    }
    __syncthreads();
}

__device__ __forceinline__ void phase_scan(KP P) {
    unsigned char* ws = sopq(GP(P->ws));
    float* Sb = (float*)(ws + OFF_S1); const float* Ds = (const float*)(ws + OFF_DSEG);
    const int N = gridDim.x * 512;
    for (int e4 = blockIdx.x * 512 + otid(); e4 < 32 * 4096; e4 += N) {
        const int bh = e4 >> 12, idx = (e4 & 4095) * 4;
        const int ln = idx & 63, r = (idx >> 6) & 3, dt = (idx >> 8) & 7, d = 16 * dt + 4 * (ln >> 4) + r;
        f32x4 run = (f32x4){0.f, 0.f, 0.f, 0.f};
#pragma unroll 1
        for (int s0 = 0; s0 < NSEG; s0 += 8) {
            f32x4 loc[8]; float dd[8];
#pragma unroll
            for (int k = 0; k < 8; ++k) {
                const int seg = s0 + k;
                if (seg < NSEG - 1) { loc[k] = *(const f32x4*)(Sb + ((size_t)(bh * NSEG + seg)) * 16384 + idx); dd[k] = Ds[(size_t)(bh * NSEG + seg) * 128 + d]; }
                else { loc[k] = (f32x4){0.f, 0.f, 0.f, 0.f}; dd[k] = 0.f; }
            }
            asm volatile("" ::: "memory");
#pragma unroll
            for (int k = 0; k < 8; ++k) {
                const int seg = s0 + k;
                *(f32x4*)(Sb + ((size_t)(bh * NSEG + seg)) * 16384 + idx) = run;
                run = run * dd[k] + loc[k];
            }
            asm volatile("" ::: "memory");
        }
    }
}

__device__ __forceinline__ void phase_ln(KP P, const half_t* src, const float* g, const float* b, half_t* o16, float* o32, unsigned short* ob16 = nullptr) {
    constexpr int NR = 4;
    const int tidl = otid(); const int lane = tidl & 63, gw = blockIdx.x * 8 + (tidl >> 6), stride = gridDim.x * 8;
    for (int row0 = gw; row0 < T; row0 += NR * stride) {
        h8 a[NR], c[NR];
#pragma unroll
        for (int r = 0; r < NR; ++r) { const int row = row0 + r * stride < T ? row0 + r * stride : row0; const half_t* xr = src + (size_t)row * DM; a[r] = __builtin_nontemporal_load((const h8*)(xr + 8 * lane)); c[r] = __builtin_nontemporal_load((const h8*)(xr + 512 + 8 * lane)); }
        asm volatile("" ::: "memory");
#pragma unroll
        for (int r = 0; r < NR; ++r) {
            const int row = row0 + r * stride;
            if (row < T) {
                float v[16]; float s1 = 0.f;
#pragma unroll
                for (int i = 0; i < 8; ++i) { v[i] = (float)a[r][i]; v[8 + i] = (float)c[r][i]; s1 += v[i] + v[8 + i]; }
                const float mean = wave_sum(s1) * (1.f / DM); float s2 = 0.f;
#pragma unroll
                for (int i = 0; i < 16; ++i) { v[i] -= mean; s2 += v[i] * v[i]; }
                const float rstd = 1.f / sqrtf(wave_sum(s2) * (1.f / DM) + 1e-5f);
#pragma unroll
                for (int hf = 0; hf < 2; ++hf) {
                    const int col = 512 * hf + 8 * lane;
                    const f32x4 g0 = *(const f32x4*)(g + col), g1 = *(const f32x4*)(g + col + 4), b0 = *(const f32x4*)(b + col), b1 = *(const f32x4*)(b + col + 4);
                    f32x4 y0, y1;
#pragma unroll
                    for (int j = 0; j < 4; ++j) { y0[j] = v[8 * hf + j] * rstd * g0[j] + b0[j]; y1[j] = v[8 * hf + 4 + j] * rstd * g1[j] + b1[j]; }
                    if (o16) *(h8*)(o16 + (size_t)row * DM + col) = pack8(y0, y1);
                    if (ob16) *(s8v*)(ob16 + (size_t)row * DM + col) = pack8b(y0, y1);
                    if (o32) { *(f32x4*)(o32 + (size_t)row * DM + col) = y0; *(f32x4*)(o32 + (size_t)row * DM + col + 4) = y1; }
                }
            }
        }
    }
}

#define XB_TMO      128
#define XB_XCNT(j)  (256  + 64 * (j))
#define XB_XSUB(j)  (1280 + 64 * (j))
#define XB_XGEN(j)  (2304 + 64 * (j))
#define XB_TOP      3328
#define XB_TOPGEN   3392
#define XCD_BAR_WORDS 3456
#define XB_SPIN_CAP (1u << 18)
__device__ __forceinline__ unsigned xb_ld(unsigned* p)              { return __hip_atomic_load(p, __ATOMIC_RELAXED, __HIP_MEMORY_SCOPE_AGENT); }
__device__ __forceinline__ unsigned xb_add(unsigned* p, unsigned v) { return __hip_atomic_fetch_add(p, v, __ATOMIC_RELAXED, __HIP_MEMORY_SCOPE_AGENT); }
__device__ __forceinline__ unsigned xb_xcc_id() { return (unsigned)__builtin_amdgcn_s_getreg((3 << 11) | 20) & 0xFu; }
#define XB_SPIN(cond, bar) do { unsigned _sp = 0; while (cond) { __builtin_amdgcn_s_sleep(1); \
    if ((++_sp & 255u) == 0u) { if (xb_ld(&(bar)[XB_TMO])) break; if (_sp > XB_SPIN_CAP) { atomicAdd(&(bar)[XB_TMO], 1u); break; } } } } while (0)
struct XcdBarrier { unsigned* bar; unsigned x; volatile LAS unsigned* st; };
__device__ __forceinline__ XcdBarrier xcd_barrier_post(unsigned* bar, volatile LAS unsigned* st) {
    XcdBarrier b; b.bar = bar; b.x = xb_xcc_id(); b.st = st;
    if (otid() == 0) (void)xb_add(&bar[XB_XCNT(b.x)], 1u);
    return b;
}
__device__ __forceinline__ void xcd_barrier_complete(unsigned* bar, unsigned x, unsigned& nloc, unsigned& nx) {
    const unsigned G = gridDim.x * gridDim.y * gridDim.z;
    unsigned sum, cnt, mine, sp = 0u;
    for (;;) {
        sum = 0u; cnt = 0u; mine = 0u;
#pragma unroll
        for (unsigned j = 0; j < 16; ++j) { const unsigned c = xb_ld(&bar[XB_XCNT(j)]); sum += c; cnt += (c > 0u) ? 1u : 0u; mine = (j == x) ? c : mine; }
        if (sum == G) break;
        __builtin_amdgcn_s_sleep(1);
        if ((++sp & 255u) == 0u) { if (xb_ld(&bar[XB_TMO])) break; if (sp > XB_SPIN_CAP) { atomicAdd(&bar[XB_TMO], 1u); break; } }
    }
    nloc = mine > 0u ? mine : 1u; nx = cnt > 0u ? cnt : 1u;
}
__device__ __forceinline__ void xcd_barrier(const XcdBarrier& b) {
    asm volatile("s_waitcnt vmcnt(0)" ::: "memory");
    __syncthreads();
    if (otid() == 0) {
        unsigned* bar = b.bar;
        __builtin_amdgcn_s_waitcnt(0);
        unsigned nloc = b.st[0], nx = b.st[1];
        if (nloc == 0u) { xcd_barrier_complete(bar, b.x, nloc, nx); b.st[0] = nloc; b.st[1] = nx; }
        const unsigned old = xb_add(&bar[XB_XSUB(b.x)], 1u);
        const unsigned gen = old / nloc;
        if (old + 1u == (gen + 1u) * nloc) {
            __builtin_amdgcn_fence(__ATOMIC_RELEASE, "agent");
            asm volatile("s_waitcnt vmcnt(0)" ::: "memory");
            const unsigned og = xb_add(&bar[XB_TOP], 1u);
            const unsigned tg = og / nx;
            if (og + 1u == (tg + 1u) * nx) xb_add(&bar[XB_TOPGEN], 1u);
            else XB_SPIN(xb_ld(&bar[XB_TOPGEN]) == tg, bar);
            __builtin_amdgcn_fence(__ATOMIC_ACQUIRE, "agent");
            xb_add(&bar[XB_XGEN(b.x)], 1u);
            asm volatile("s_waitcnt vmcnt(0)" ::: "memory");
        } else {
            XB_SPIN(xb_ld(&bar[XB_XGEN(b.x)]) == gen, bar);
            __builtin_amdgcn_fence(__ATOMIC_ACQUIRE, "agent");
            asm volatile("s_waitcnt vmcnt(0)" ::: "memory");
        }
    }
    __syncthreads();
}

__global__ void __launch_bounds__(512, 2) mega(Params Pk) {
    KP P = kp_get();
    extern __shared__ __attribute__((aligned(16))) unsigned char shm[];
    cg::grid_group grid = cg::this_grid();
    unsigned char* ws = sopq(GP(P->ws));
    const int G = gridDim.x;
    volatile LAS unsigned* xst = (volatile LAS unsigned*)((LAS unsigned char*)shm + pg8::STAGE_BYTES);
#if USE_XCD
    if (otid() == 0) { xst[0] = 0u; xst[1] = 0u; }
    __syncthreads();
    (void)xcd_barrier_post((unsigned*)(ws + OFF_BAR), xst);
    if (P->ph1 < 0) grid.sync();
#endif
#pragma unroll 1
    for (int pi = P->ph0; pi < P->ph1; ++pi) {
        const int ph = PROG[pi];
        P = kp_get();
        unsigned char* ws = sopq(GP(P->ws));
        int gk = -1, hk = -1, bfk = 0; pg8::Gemm g; g.M = T; g.A = nullptr; g.Bt = nullptr; g.N = DM; g.K = DM;
        switch (ph) {
            case 1: gk = EK_PROJ; bfk = BF_P1; g.A = (const half_t*)(ws + OFF_S1); g.Bt = (const half_t*)(ws + OFF_WIN); g.N = DIN; g.K = DM; break;
            case 5: gk = EK_MRG; hk = 16; g.A = (const half_t*)(ws + OFF_S2); g.Bt = (const half_t*)(ws + OFF_WA); g.K = YAB; break;
            case 7: gk = EK_WO; g.A = (const half_t*)(ws + OFF_S5); g.Bt = (const half_t*)(ws + OFF_WO); break;
            case 9: gk = EK_FFN; bfk = BF_P9; g.A = (const half_t*)(ws + (BF_P9 ? OFF_S4 : OFF_S1)); g.Bt = (const half_t*)(ws + OFF_WGU); g.N = 6656; break;
            case 11: gk = EK_DOWN; hk = 4; g.A = (const half_t*)(ws + OFF_S5); g.Bt = (const half_t*)(ws + OFF_WD); g.K = HPW; break;
            default: break;
        }
        if (gk >= 0) {
            if (gk == EK_PROJ) {
                const int t0 = otid(); const float* bsrc = (const float*)(ws + OFF_BINP); const float* lsrc = (const float*)(ws + OFF_LB);
                LAS half_t* bl = (LAS half_t*)((LAS unsigned char*)shm + LDS_BIAS); LAS float* ll = (LAS float*)((LAS unsigned char*)shm + LDS_LB);
                for (int i = t0; i < DIN; i += 512) bl[i] = (half_t)bsrc[i];
                for (int i = t0; i < DM; i += 512) ll[i] = lsrc[i];
                __syncthreads();
            }
            pg8::StaticOrder S; S.init(g.M, g.N, G, blockIdx.x);
            Epi E; E.kind = gk; E.hook_t = hk; E.P = P; E.lds = (LAS unsigned char*)shm;
            if (bfk) pg8::gemm_phase<Epi, true>((LAS unsigned char*)shm, g, S, E); else pg8::gemm_phase<Epi>((LAS unsigned char*)shm, g, S, E);
        } else if (ph == 0) {
            phase_prep(P, shm);
        } else if (ph == 2) {
            for (int it = blockIdx.x; it < 256; it += G) gmlp_item(P, shm, it);
            for (int it = blockIdx.x; it < NITEM; it += 2 * G) {
                const int it1 = it + G; const bool v0 = (it % NSEG) != NSEG - 1, v1 = it1 < NITEM && (it1 % NSEG) != NSEG - 1;
                if (v0 && v1) hgrn_pairA(P, shm, it, it1);
                else { if (v0) hgrn_item<false>(P, shm, it); if (v1) hgrn_item<false>(P, shm, it1); }
            }
        } else if (ph == 3) {
            phase_scan(P);
        } else if (ph == 4) {
            for (int it = blockIdx.x; it < NITEM; it += G) hgrn_item<true>(P, shm, it);
        } else if (ph == 8) {
            phase_ln(P, (const half_t*)(ws + OFF_S3), GP(P->ln1_g), GP(P->ln1_b), (half_t*)(ws + OFF_S1), nullptr, BF_P9 ? (unsigned short*)(ws + OFF_S4) : nullptr);
            half_t* p16 = (half_t*)(ws + OFF_S5);
            {
                const int i0 = blockIdx.x * 512 + otid(), str = G * 512;
                for (int it = 0; it < 8; it += 4) {
                    f32x4 pa[4], pb[4];
#pragma unroll
                    for (int k = 0; k < 4; ++k) { const int i = i0 + (it + k) * str; const int ic = i < T * PLE / 8 ? i : i0; pa[k] = __builtin_nontemporal_load((const f32x4*)(GP(P->p) + (size_t)ic * 8)); pb[k] = __builtin_nontemporal_load((const f32x4*)(GP(P->p) + (size_t)ic * 8 + 4)); }
                    asm volatile("" ::: "memory");
#pragma unroll
                    for (int k = 0; k < 4; ++k) { const int i = i0 + (it + k) * str; if (i < T * PLE / 8) *(h8*)(p16 + (size_t)(i >> 5) * HPW + (i & 31) * 8) = pack8(pa[k], pb[k]); }
                }
                for (int i = i0 + 8 * str; i < T * PLE / 8; i += str) {
                    const f32x4 a = *(const f32x4*)(GP(P->p) + (size_t)i * 8), b = *(const f32x4*)(GP(P->p) + (size_t)i * 8 + 4);
                    *(h8*)(p16 + (size_t)(i >> 5) * HPW + (i & 31) * 8) = pack8(a, b);
                }
            }
        } else if (ph == 12) {
            phase_ln(P, (const half_t*)(ws + OFF_S3), GP(P->ln2_g), GP(P->ln2_b), nullptr, GP(P->out));
        }
        if (pi + 1 < P->ph1) {
#if USE_XCD
            { XcdBarrier xb; xb.bar = (unsigned*)(ws + OFF_BAR); xb.x = xb_xcc_id(); xb.st = xst; xcd_barrier(xb); }
#else
            grid.sync();
#endif
        }
    }
}

extern "C" void kernel_launch(void* const* d_in, const int* in_sizes, int n_in, void* d_out, int out_size, void* d_ws, size_t ws_size, hipStream_t stream) {
    static int grid = 0;
    constexpr int LDS_BYTES = LDS_TOTAL;
    if (grid == 0) {
        if (n_in != 25 || ws_size < WS_NEED || out_size != T * DM) { fprintf(stderr, "kernel_launch: unexpected shapes n_in %d ws %zu out %d\n", n_in, ws_size, out_size); grid = -1; return; }
        int dev = 0, cus = 0, per_cu = 0;
        hipGetDevice(&dev);
        hipDeviceGetAttribute(&cus, hipDeviceAttributeMultiprocessorCount, dev);
        hipFuncSetAttribute((const void*)mega, hipFuncAttributeMaxDynamicSharedMemorySize, LDS_BYTES);
        hipOccupancyMaxActiveBlocksPerMultiprocessor(&per_cu, (const void*)mega, 512, LDS_BYTES);
        if (per_cu < 1) { fprintf(stderr, "kernel_launch: occupancy query says %d blocks per CU\n", per_cu); per_cu = 1; }
        (void)hipGetLastError();
        grid = cus;
    }
    if (grid < 0) return;
    Params P{};
#if USE_XCD && !MK_MULTI
    (void)hipMemsetAsync((unsigned char*)d_ws + OFF_BAR, 0, XCD_BAR_WORDS * 4, stream);
#endif
    const float** f = (const float**)&P;
    for (int i = 0; i < 25; ++i) f[i] = (const float*)d_in[i];
    P.out = (float*)d_out; P.ws = (unsigned char*)d_ws;
#if MK_MULTI
    for (int ph = 0; ph < NPH; ++ph) {
        P.ph0 = ph; P.ph1 = ph + 1;
        void* args[] = {&P};
        hipError_t e = hipLaunchCooperativeKernel((const void*)mega, dim3(grid), dim3(512), args, LDS_BYTES, stream);
        if (e != hipSuccess) fprintf(stderr, "launch failed: %s\n", hipGetErrorString(e));
    }
#else
    P.ph0 = 0; P.ph1 = NPH;
    void* args[] = {&P};
    hipError_t e = hipLaunchCooperativeKernel((const void*)mega, dim3(grid), dim3(512), args, LDS_BYTES, stream);
    if (e != hipSuccess) fprintf(stderr, "cooperative launch failed: %s (grid %d)\n", hipGetErrorString(e), grid);
#endif
}
```
